# Optimizing an MI355X kernel written in HIP

```python
import math
import jax
import jax.numpy as jnp
from jax import lax
import numpy as np

D_MODEL = 2048
BATCH = 4
SEQ = 4096
DEPTH = 2

CTX_LEN = 256
GRID_W = 64
N_EVEN = (DEPTH + 1) // 2
N_ODD = DEPTH // 2
EPS = 1e-6
F32 = jnp.float32

HG_HEADS = 8
HG_DK = 128
HG_DV = 128
HG_KW = HG_HEADS * HG_DK
HG_VW = HG_HEADS * HG_DV
HG_CHUNK = 64

LRU_WIDTH = 1024
LRU_HEADS = 8
LRU_BLOCK = LRU_WIDTH // LRU_HEADS
LRU_CONV = 4
LRU_C = 8.0

MLA_HEADS = 8
MLA_Q_LORA = 512
MLA_KV_LORA = 512
MLA_NOPE = 128
MLA_ROPE = 64
MLA_V = 128
ROPE_THETA = 10000.0
ATTN_BLOCK = 128

SSD_WIDTH = 1024
SSD_HEADDIM = 64
SSD_HEADS = SSD_WIDTH // SSD_HEADDIM
SSD_GROUPS = 2
SSD_STATE = 128
SSD_BC = SSD_GROUPS * SSD_STATE
SSD_XBC = SSD_WIDTH + 2 * SSD_BC
SSD_CONV = 4
SSD_CHUNK = 128

N_EXPERTS = 16
EXPERT_FF = 1408
CAPACITY_FACTOR = 2

EV_OUT = HG_KW + HG_VW + LRU_WIDTH
EV_STATE = 2 * HG_KW + HG_VW + LRU_WIDTH
EV_IN = EV_OUT + EV_STATE
OD_OUT = MLA_Q_LORA + SSD_WIDTH
OD_STATE = MLA_KV_LORA + MLA_ROPE + SSD_XBC + 2 * SSD_HEADS
OD_IN = OD_OUT + OD_STATE
MIX_WIDTH = HG_VW + LRU_WIDTH

kernel_name = 'hybrid_dit_hgrn2_rglru_mla_ssd_ecmoe'


def rmsnorm(x, g):
    xf = x.astype(F32)
    y = xf * lax.rsqrt(jnp.mean(xf * xf, axis=-1, keepdims=True) + EPS)
    return (y * g.astype(F32)).astype(x.dtype)


def heads(t, h):
    return t.reshape(t.shape[0], t.shape[1], h, t.shape[-1] // h)


def flip(t):
    return jnp.flip(t, axis=1)


def dwconv(x, w, b):
    k = w.shape[0]
    y = lax.conv_general_dilated(x, w[:, None, :].astype(x.dtype), window_strides=(1,), padding=[(k // 2, k - 1 - k // 2)], dimension_numbers=('NWC', 'WIO', 'NWC'), feature_group_count=x.shape[-1])
    return y + b.astype(x.dtype)


def axial_rope(rows):
    row = jnp.repeat(jnp.arange(rows, dtype=F32), GRID_W)
    col = jnp.arange(rows * GRID_W) % GRID_W
    n_freq = MLA_ROPE // 4
    inv = ROPE_THETA ** (-jnp.arange(n_freq, dtype=F32) / n_freq)
    ang = jnp.concatenate([row[:, None] * inv, col.astype(F32)[:, None] * inv], axis=-1)
    return jnp.cos(ang), jnp.sin(ang)


def apply_rope(t, cos, sin):
    t1, t2 = jnp.split(t.astype(F32), 2, axis=-1)
    cs, sn = cos[None, :, None, :], sin[None, :, None, :]
    return jnp.concatenate([t1 * cs - t2 * sn, t1 * sn + t2 * cs], axis=-1).astype(t.dtype)


def segsum(x):
    t = x.shape[-1]
    xx = jnp.broadcast_to(x[..., :, None], x.shape + (t,))
    xx = jnp.where(jnp.tril(jnp.ones((t, t), bool), -1), xx, 0.0)
    cs = jnp.cumsum(xx, axis=-2)
    return jnp.where(jnp.tril(jnp.ones((t, t), bool)), cs, -jnp.inf)


def gla_chunked(q, k, v, logf, s0):
    b, t, h, _ = k.shape
    dv = v.shape[-1]
    n = t // HG_CHUNK
    blk = lambda a: a.reshape(b, n, HG_CHUNK, h, a.shape[-1])
    k, v, g = blk(k), blk(v), jnp.cumsum(blk(logf), axis=2)
    g_last = g[:, :, -1:]
    ds = jnp.einsum('bnmhd,bnmhe->bnhde', k * jnp.exp(g_last - g), v)
    decay = jnp.exp(g_last[:, :, 0])

    def step(s, inp):
        dec, d = inp
        return dec[..., None] * s + d, s

    s_fin, s_prev = lax.scan(step, s0, (jnp.moveaxis(decay, 1, 0), jnp.moveaxis(ds, 1, 0)))
    if q is None:
        return None, s_fin
    qg = blk(q) * jnp.exp(g)
    att = jnp.einsum('bnlhd,bnmhd->bnhlm', qg, k * jnp.exp(-g))
    att = jnp.where(jnp.tril(jnp.ones((HG_CHUNK, HG_CHUNK), bool)), att, 0.0)
    o = jnp.einsum('bnhlm,bnmhe->bnlhe', att, v) + jnp.einsum('bnlhd,nbhde->bnlhe', qg, s_prev)
    return o.reshape(b, t, h, dv), s_fin


def hgrn2_scan(q_c, f_c, i_c, q_l, f_l, i_l, lb):
    def gates(fr):
        f = lb + (1.0 - lb) * jax.nn.sigmoid(fr.astype(F32))
        return heads(jnp.log(f), HG_HEADS), heads(1.0 - f, HG_HEADS)

    s0 = jnp.zeros((f_l.shape[0], HG_HEADS, HG_DK, HG_DV), F32)
    lf, k = gates(f_c)
    o_c, s_c = gla_chunked(q_c, k, i_c, lf, s0)
    lf, k = gates(f_l)
    o_l, _ = gla_chunked(q_l, k, i_l, lf, s_c)
    return o_c, o_l


def linear_scan(a, b, h0):
    def comb(lft, rgt):
        return lft[0] * rgt[0], rgt[0] * lft[1] + rgt[1]

    a_cum, h = lax.associative_scan(comb, (a, b), axis=1)
    return h + a_cum * h0[:, None, :]


def rglru_scan(x_c, x_l, wa, ba, wx, bx, lam):
    def gates(xs):
        xh = heads(xs, LRU_HEADS)
        r = jax.nn.sigmoid(jnp.einsum('bthi,hij->bthj', xh, wa).reshape(xs.shape).astype(F32) + ba)
        ig = jax.nn.sigmoid(jnp.einsum('bthi,hij->bthj', xh, wx).reshape(xs.shape).astype(F32) + bx)
        log_a = -LRU_C * r * jax.nn.softplus(-lam.astype(F32))
        return jnp.exp(log_a), jnp.sqrt(-jnp.expm1(2.0 * log_a)) * ig * xs

    a, bb = gates(x_c)
    h_c = linear_scan(a, bb, jnp.zeros((x_c.shape[0], LRU_WIDTH), F32))
    a, bb = gates(x_l)
    h_l = linear_scan(a, bb, h_c[:, -1])
    return h_c, h_l


def even_mixer(u_c, u_l, lb_f, lb_b, onorm, conv_w, conv_b, wa, ba, wx, bx, lam, need_ctx):
    def split_state(u):
        f_f, f_b, i, lx = jnp.split(u, [HG_KW, 2 * HG_KW, 2 * HG_KW + HG_VW], axis=-1)
        return f_f, f_b, heads(i, HG_HEADS), lx

    def split_out(u):
        q, g, lg = jnp.split(u, [HG_KW, HG_KW + HG_VW], axis=-1)
        return heads(jax.nn.silu(q), HG_HEADS), g, lg

    q_l, g_l, lg_l = split_out(u_l[..., :EV_OUT])
    ff_l, fb_l, i_l, lx_l = split_state(u_l[..., EV_OUT:])
    if need_ctx:
        q_c, g_c, lg_c = split_out(u_c[..., :EV_OUT])
        u_c = u_c[..., EV_OUT:]
        q_cb = flip(q_c)
    else:
        q_c, q_cb = None, None
    ff_c, fb_c, i_c, lx_c = split_state(u_c)

    oc_f, ol_f = hgrn2_scan(q_c, ff_c, i_c, q_l, ff_l, i_l, lb_f)
    oc_b, ol_b = hgrn2_scan(q_cb, flip(fb_c), flip(i_c), flip(q_l), flip(fb_l), flip(i_l), lb_b)
    hg_gain = onorm.reshape(HG_HEADS, HG_DV)

    def hg_out(o, g):
        return rmsnorm(o, hg_gain).reshape(g.shape) * jax.nn.silu(g.astype(F32))

    x_c = dwconv(lx_c, conv_w, conv_b)
    x_l = dwconv(lx_l, conv_w, conv_b)
    hc_f, hl_f = rglru_scan(x_c, x_l, wa[0], ba[0], wx[0], bx[0], lam[0])
    hc_b, hl_b = rglru_scan(flip(x_c), flip(x_l), wa[1], ba[1], wx[1], bx[1], lam[1])

    y_l = jnp.concatenate([hg_out(ol_f + flip(ol_b), g_l), (hl_f + flip(hl_b)) * jax.nn.gelu(lg_l.astype(F32))], axis=-1).astype(u_l.dtype)
    if not need_ctx:
        return None, y_l
    y_c = jnp.concatenate([hg_out(oc_f + flip(oc_b), g_c), (hc_f + flip(hc_b)) * jax.nn.gelu(lg_c.astype(F32))], axis=-1).astype(u_l.dtype)
    return y_c, y_l


def block_attention(q, k, v):
    b, t, h, dq = q.shape
    nb = t // ATTN_BLOCK
    scale = dq ** -0.5
    qb = jnp.moveaxis(q.reshape(b, nb, ATTN_BLOCK, h, dq), 1, 0)

    def one(qblk):
        s = jnp.einsum('bqhd,bkhd->bhqk', qblk, k).astype(F32) * scale
        p = jax.nn.softmax(s, axis=-1).astype(v.dtype)
        return jnp.einsum('bhqk,bkhe->bqhe', p, v)

    o = lax.map(one, qb)
    return jnp.moveaxis(o, 0, 1).reshape(b, t, h, v.shape[-1])


def ssd_chunked(x, dt, a, bm, cm, s0, want_y):
    b, t, h, p = x.shape
    n_c = t // SSD_CHUNK
    rep = h // bm.shape[2]
    blk = lambda z: z.reshape(b, n_c, SSD_CHUNK, *z.shape[2:])
    xdt = blk(x * dt[..., None])
    bh = blk(jnp.repeat(bm, rep, axis=2))
    a_dt = jnp.moveaxis(blk(dt * a), 3, 1)
    a_cs = jnp.cumsum(a_dt, axis=-1)
    states = jnp.einsum('bclhn,bhcl,bclhp->bchpn', bh, jnp.exp(a_cs[..., -1:] - a_cs), xdt)
    states = jnp.concatenate([s0[:, None], states], axis=1)
    chunk_decay = jnp.exp(segsum(jnp.pad(a_cs[..., -1], ((0, 0), (0, 0), (1, 0)))))
    new_states = jnp.einsum('bhzc,bchpn->bzhpn', chunk_decay, states)
    if not want_y:
        return None, new_states[:, -1]
    ch = blk(jnp.repeat(cm, rep, axis=2))
    scores = jnp.einsum('bclhn,bcshn->bhcls', ch, bh) * jnp.exp(segsum(a_dt))
    y = jnp.einsum('bhcls,bcshp->bclhp', scores, xdt) + jnp.einsum('bclhn,bchpn,bhcl->bclhp', ch, new_states[:, :-1], jnp.exp(a_cs))
    return y.reshape(b, t, h, p), new_states[:, -1]


def odd_mixer(u_c, u_l, q_norm, w_q_up, kv_norm, w_kv_up, conv_w, conv_b, dt_bias, a_log, d_skip, onorm, cos, sin, need_ctx):
    def mla_q(lo, use_rope):
        qq = heads(rmsnorm(lo[..., :MLA_Q_LORA], q_norm) @ w_q_up, MLA_HEADS)
        if use_rope:
            qq = jnp.concatenate([qq[..., :MLA_NOPE], apply_rope(qq[..., MLA_NOPE:], cos, sin)], axis=-1)
        return qq

    def mla_kv(st, use_rope):
        kv = heads(rmsnorm(st[..., :MLA_KV_LORA], kv_norm) @ w_kv_up, MLA_HEADS)
        k_nope, v = kv[..., :MLA_NOPE], kv[..., MLA_NOPE:]
        k_r = st[..., MLA_KV_LORA:MLA_KV_LORA + MLA_ROPE][:, :, None, :]
        if use_rope:
            k_r = apply_rope(k_r, cos, sin)
        k_r = jnp.broadcast_to(k_r, k_nope.shape[:3] + (MLA_ROPE,))
        return jnp.concatenate([k_nope, k_r], axis=-1), v

    def ssd_in(st):
        o = MLA_KV_LORA + MLA_ROPE
        xbc = jax.nn.silu(dwconv(st[..., o:o + SSD_XBC], conv_w, conv_b))
        xs = heads(xbc[..., :SSD_WIDTH], SSD_HEADS)
        bm = heads(xbc[..., SSD_WIDTH:SSD_WIDTH + SSD_BC], SSD_GROUPS)
        cm = heads(xbc[..., SSD_WIDTH + SSD_BC:], SSD_GROUPS)
        return [xs, bm, cm, st[..., o + SSD_XBC:].astype(F32)]

    def ssd_dir(inp_c, inp_l, d):
        a = -jnp.exp(a_log[d].astype(F32))

        def run(inp, s0, want_y):
            xs, bm, cm, dtr = inp
            dt = jax.nn.softplus(dtr[..., d * SSD_HEADS:(d + 1) * SSD_HEADS] + dt_bias[d].astype(F32))
            return ssd_chunked(xs, dt, a, bm, cm, s0, want_y)

        s0 = jnp.zeros((inp_l[0].shape[0], SSD_HEADS, SSD_HEADDIM, SSD_STATE), F32)
        y_c, s_c = run(inp_c, s0, need_ctx)
        y_l, _ = run(inp_l, s_c, True)
        return y_c, y_l

    def ssd_out(y, xs, z):
        y = (y + d_skip.astype(F32)[:, None] * xs).reshape(z.shape) * jax.nn.silu(z.astype(F32))
        return rmsnorm(heads(y, SSD_GROUPS), onorm.reshape(SSD_GROUPS, -1)).reshape(z.shape)

    lo_l, st_l = u_l[..., :OD_OUT], u_l[..., OD_OUT:]
    st_c = u_c[..., OD_OUT:] if need_ctx else u_c
    b, s = u_l.shape[:2]

    k_c, v_c = mla_kv(st_c, False)
    k_l, v_l = mla_kv(st_l, True)
    att_l = block_attention(mla_q(lo_l, True), jnp.concatenate([k_c, k_l], axis=1), jnp.concatenate([v_c, v_l], axis=1))

    in_c, in_l = ssd_in(st_c), ssd_in(st_l)
    yc_f, yl_f = ssd_dir(in_c, in_l, 0)
    yc_b, yl_b = ssd_dir([flip(t) for t in in_c], [flip(t) for t in in_l], 1)

    y_l = jnp.concatenate([att_l.reshape(b, s, -1), ssd_out(yl_f + flip(yl_b), in_l[0], lo_l[..., MLA_Q_LORA:])], axis=-1).astype(u_l.dtype)
    if not need_ctx:
        return None, y_l
    lo_c = u_c[..., :OD_OUT]
    att_c = block_attention(mla_q(lo_c, False), k_c, v_c)
    y_c = jnp.concatenate([att_c.reshape(b, u_c.shape[1], -1), ssd_out(yc_f + flip(yc_b), in_c[0], lo_c[..., MLA_Q_LORA:])], axis=-1).astype(u_l.dtype)
    return y_c, y_l


def ec_moe(h, w_router, w_gate, w_up, w_down):
    b, t, _ = h.shape
    cap = CAPACITY_FACTOR * t // N_EXPERTS
    aff = jax.nn.softmax((h @ w_router).astype(F32), axis=-1)
    gate, idx = lax.top_k(jnp.swapaxes(aff, 1, 2), cap)
    bidx = jnp.arange(b)[:, None, None]
    xe = h[bidx, idx]
    hid = jax.nn.silu(jnp.einsum('becd,edf->becf', xe, w_gate)) * jnp.einsum('becd,edf->becf', xe, w_up)
    ye = jnp.einsum('becf,efd->becd', hid, w_down) * gate[..., None].astype(h.dtype)
    return jnp.zeros_like(h).at[bidx, idx].add(ye)


def setup_inputs(seed: int = 0) -> dict:
    key = jax.random.key(seed)
    ks = iter(jax.random.split(key, 48))
    D = D_MODEL

    def nrm(shape, scale):
        return jax.random.normal(next(ks), shape, F32) * scale

    def gain(shape):
        return 1.0 + nrm(shape, 0.01)

    a0 = jax.random.uniform(next(ks), (N_EVEN, 2, LRU_WIDTH), F32, minval=0.9, maxval=0.999)
    s_lam = a0 ** (1.0 / LRU_C)
    lru_lambda = jnp.log(s_lam) - jnp.log1p(-s_lam)
    dt0 = jnp.exp(jax.random.uniform(next(ks), (N_ODD, 2, SSD_HEADS), F32, minval=math.log(1e-3), maxval=math.log(1e-1)))
    ssd_dt_bias = dt0 + jnp.log(-jnp.expm1(-dt0))
    ssd_a_log = jnp.log(jax.random.uniform(next(ks), (N_ODD, 2, SSD_HEADS), F32, minval=1.0, maxval=16.0))
    return {
        'x': nrm((BATCH, SEQ, D), 1.0),
        'c': nrm((BATCH, D), 1.0),
        'ctx': nrm((BATCH, CTX_LEN, D), 1.0),
        'c_ctx': nrm((D,), 1.0),
        'w_mod': nrm((DEPTH, D, 6 * D), 0.5 * D ** -0.5),
        'b_mod': nrm((DEPTH, 6 * D), 0.01),
        'norm_mix': gain((DEPTH, D)),
        'norm_ffn': gain((DEPTH, D)),
        'w_out': nrm((DEPTH, MIX_WIDTH, D), MIX_WIDTH ** -0.5),
        'ev_w_in': nrm((N_EVEN, D, EV_IN), D ** -0.5),
        'hg_lb': nrm((2, N_EVEN + 1, HG_KW), 0.1),
        'hg_onorm': gain((N_EVEN, HG_VW)),
        'lru_conv_w': nrm((N_EVEN, LRU_CONV, LRU_WIDTH), LRU_CONV ** -0.5),
        'lru_conv_b': nrm((N_EVEN, LRU_WIDTH), 0.01),
        'lru_wa': nrm((N_EVEN, 2, LRU_HEADS, LRU_BLOCK, LRU_BLOCK), LRU_BLOCK ** -0.5),
        'lru_ba': nrm((N_EVEN, 2, LRU_WIDTH), 0.01),
        'lru_wx': nrm((N_EVEN, 2, LRU_HEADS, LRU_BLOCK, LRU_BLOCK), LRU_BLOCK ** -0.5),
        'lru_bx': nrm((N_EVEN, 2, LRU_WIDTH), 0.01),
        'lru_lambda': lru_lambda,
        'od_w_in': nrm((N_ODD, D, OD_IN), D ** -0.5),
        'mla_q_norm': gain((N_ODD, MLA_Q_LORA)),
        'mla_w_q_up': nrm((N_ODD, MLA_Q_LORA, MLA_HEADS * (MLA_NOPE + MLA_ROPE)), MLA_Q_LORA ** -0.5),
        'mla_kv_norm': gain((N_ODD, MLA_KV_LORA)),
        'mla_w_kv_up': nrm((N_ODD, MLA_KV_LORA, MLA_HEADS * (MLA_NOPE + MLA_V)), MLA_KV_LORA ** -0.5),
        'ssd_conv_w': nrm((N_ODD, SSD_CONV, SSD_XBC), SSD_CONV ** -0.5),
        'ssd_conv_b': nrm((N_ODD, SSD_XBC), 0.01),
        'ssd_dt_bias': ssd_dt_bias,
        'ssd_a_log': ssd_a_log,
        'ssd_d': 1.0 + nrm((N_ODD, SSD_HEADS), 0.1),
        'ssd_onorm': gain((N_ODD, SSD_WIDTH)),
        'moe_router': nrm((DEPTH, D, N_EXPERTS), D ** -0.5),
        'moe_w_gate': nrm((DEPTH, N_EXPERTS, D, EXPERT_FF), D ** -0.5),
        'moe_w_up': nrm((DEPTH, N_EXPERTS, D, EXPERT_FF), D ** -0.5),
        'moe_w_down': nrm((DEPTH, N_EXPERTS, EXPERT_FF, D), EXPERT_FF ** -0.5),
        'final_norm': gain((D,)),
    }


def reference(x, c, ctx, c_ctx, w_mod, b_mod, norm_mix, norm_ffn, w_out, ev_w_in, hg_lb, hg_onorm, lru_conv_w, lru_conv_b, lru_wa, lru_ba, lru_wx, lru_bx, lru_lambda, od_w_in, mla_q_norm, mla_w_q_up, mla_kv_norm, mla_w_kv_up, ssd_conv_w, ssd_conv_b, ssd_dt_bias, ssd_a_log, ssd_d, ssd_onorm, moe_router, moe_w_gate, moe_w_up, moe_w_down, final_norm):
    rows = x.shape[1] // GRID_W
    cos, sin = axial_rope(rows)
    lb_all = jnp.cumsum(jax.nn.softmax(hg_lb.astype(F32), axis=1), axis=1)
    for l in range(DEPTH):
        need_ctx = l < DEPTH - 1
        j = l // 2
        mod = jax.nn.silu(c) @ w_mod[l] + b_mod[l]
        mod_c = jax.nn.silu(c_ctx) @ w_mod[l] + b_mod[l]
        sh1, sc1, g1, sh2, sc2, g2 = jnp.split(mod[:, None, :], 6, axis=-1)
        csh1, csc1, cg1, csh2, csc2, cg2 = jnp.split(mod_c, 6, axis=-1)
        h_l = rmsnorm(x, norm_mix[l]) * (1.0 + sc1) + sh1
        h_c = rmsnorm(ctx, norm_mix[l]) * (1.0 + csc1) + csh1
        if l % 2 == 0:
            w_in = ev_w_in[j]
            u_c = h_c @ (w_in if need_ctx else w_in[:, EV_OUT:])
            o_c, o_l = even_mixer(u_c, h_l @ w_in, lb_all[0, j], lb_all[1, j], hg_onorm[j], lru_conv_w[j], lru_conv_b[j], lru_wa[j], lru_ba[j], lru_wx[j], lru_bx[j], lru_lambda[j], need_ctx)
        else:
            w_in = od_w_in[j]
            u_c = h_c @ (w_in if need_ctx else w_in[:, OD_OUT:])
            o_c, o_l = odd_mixer(u_c, h_l @ w_in, mla_q_norm[j], mla_w_q_up[j], mla_kv_norm[j], mla_w_kv_up[j], ssd_conv_w[j], ssd_conv_b[j], ssd_dt_bias[j], ssd_a_log[j], ssd_d[j], ssd_onorm[j], cos, sin, need_ctx)
        x = x + g1 * (o_l @ w_out[l])
        x = x + g2 * ec_moe(rmsnorm(x, norm_ffn[l]) * (1.0 + sc2) + sh2, moe_router[l], moe_w_gate[l], moe_w_up[l], moe_w_down[l])
        if need_ctx:
            ctx = ctx + cg1 * (o_c @ w_out[l])
            ctx = ctx + cg2 * ec_moe(rmsnorm(ctx, norm_ffn[l]) * (1.0 + csc2) + csh2, moe_router[l], moe_w_gate[l], moe_w_up[l], moe_w_down[l])
    return rmsnorm(x, final_norm)
```

```cpp
#include <hip/hip_runtime.h>
#include <cstdio>
#include <cstdint>
#include <cstring>

#define LAS __attribute__((address_space(3)))
typedef unsigned short bf16_t;
typedef short bf16x8 __attribute__((ext_vector_type(8)));
typedef short s16x4 __attribute__((ext_vector_type(4)));
typedef float f32x2 __attribute__((ext_vector_type(2)));
typedef float f32x4 __attribute__((ext_vector_type(4)));
typedef float f32x8 __attribute__((ext_vector_type(8)));
typedef float f32x16 __attribute__((ext_vector_type(16)));
typedef unsigned u32x2 __attribute__((ext_vector_type(2)));
typedef unsigned u32x4 __attribute__((ext_vector_type(4)));

constexpr int D = 2048, NB = 4, TL = 4096, TC = 256, RL = NB * TL, RC = NB * TC, R = RL + RC;
constexpr int EVN = 7168, ODN = 3840, ODSRC = 3680;
constexpr int NE = 16, FF = 1408, GUN = 2816, CAPL = 512, CAPC = 32;
constexpr int KSEQ = TC + TL;
constexpr float EPS = 1e-6f;
constexpr int NWAVES = 8, NTHR = 512;
constexpr int MODS = 32;

__device__ __forceinline__ float bf2f(unsigned short b) { return __uint_as_float(((unsigned)b) << 16); }
__device__ __forceinline__ float bflo(unsigned w) { return __uint_as_float(w << 16); }
__device__ __forceinline__ float bfhi(unsigned w) { return __uint_as_float(w & 0xffff0000u); }
__device__ __forceinline__ unsigned short f2bf(float f) { unsigned u = __float_as_uint(f); u += 0x7fffu + ((u >> 16) & 1u); return (unsigned short)(u >> 16); }
typedef __bf16 bf16x2_t __attribute__((ext_vector_type(2)));
__device__ __forceinline__ unsigned pk2c(float lo, float hi) { const bf16x2_t v = __builtin_convertvector((f32x2){lo, hi}, bf16x2_t); return __builtin_bit_cast(unsigned, v); }
__device__ __forceinline__ unsigned pk2(float lo, float hi) { unsigned r; asm volatile("v_cvt_pk_bf16_f32 %0, %1, %2" : "=v"(r) : "v"(lo), "v"(hi)); return r; }
__device__ __forceinline__ float sigmoidf_(float x) { return __builtin_amdgcn_rcpf(1.0f + __expf(-x)); }
__device__ __forceinline__ float siluf_(float x) { return x * __builtin_amdgcn_rcpf(1.0f + __expf(-x)); }
__device__ __forceinline__ float softplusf_(float x) { return x > 20.f ? x : log1pf(__expf(x)); }
__device__ __forceinline__ float gelu_tanh_(float x) { const float u = 0.7978845608028654f * (x + 0.044715f * x * x * x); return x * (1.0f - __builtin_amdgcn_rcpf(1.0f + __expf(2.0f * u))); }
__device__ __forceinline__ float wave_sum(float v) {
#pragma unroll
    for (int o = 1; o < 64; o <<= 1) v += __shfl_xor(v, o);
    return v;
}
__device__ __forceinline__ float wave_max(float v) {
#pragma unroll
    for (int o = 1; o < 64; o <<= 1) v = fmaxf(v, __shfl_xor(v, o));
    return v;
}
#define LDS_WAIT() asm volatile("s_waitcnt lgkmcnt(0)" ::: "memory")
#define VM_WAIT() asm volatile("s_waitcnt vmcnt(0)" ::: "memory")

__device__ __forceinline__ void load_row_f32(const float* row, int lane, float (&v)[32]) {
#pragma unroll
    for (int j = 0; j < 4; ++j) { const f32x4* p = (const f32x4*)(row + (j * 64 + lane) * 8); const f32x4 a = p[0], b = p[1];
        v[8 * j + 0] = a[0]; v[8 * j + 1] = a[1]; v[8 * j + 2] = a[2]; v[8 * j + 3] = a[3]; v[8 * j + 4] = b[0]; v[8 * j + 5] = b[1]; v[8 * j + 6] = b[2]; v[8 * j + 7] = b[3]; }
}
__device__ __forceinline__ void store_row_f32(float* row, int lane, const float (&v)[32]) {
#pragma unroll
    for (int j = 0; j < 4; ++j) { f32x4* p = (f32x4*)(row + (j * 64 + lane) * 8);
        p[0] = (f32x4){v[8 * j + 0], v[8 * j + 1], v[8 * j + 2], v[8 * j + 3]}; p[1] = (f32x4){v[8 * j + 4], v[8 * j + 5], v[8 * j + 6], v[8 * j + 7]}; }
}
__device__ __forceinline__ void store_row_bf16(bf16_t* row, int lane, const float (&v)[32]) {
#pragma unroll
    for (int j = 0; j < 4; ++j) { u32x4 w; w.x = pk2(v[8 * j + 0], v[8 * j + 1]); w.y = pk2(v[8 * j + 2], v[8 * j + 3]); w.z = pk2(v[8 * j + 4], v[8 * j + 5]); w.w = pk2(v[8 * j + 6], v[8 * j + 7]);
        *(u32x4*)(row + (j * 64 + lane) * 8) = w; }
}
__device__ __forceinline__ void load_row_bf16(const bf16_t* row, int lane, float (&v)[32]) {
#pragma unroll
    for (int j = 0; j < 4; ++j) { const u32x4 w = *(const u32x4*)(row + (j * 64 + lane) * 8);
        v[8 * j + 0] = bflo(w.x); v[8 * j + 1] = bfhi(w.x); v[8 * j + 2] = bflo(w.y); v[8 * j + 3] = bfhi(w.y); v[8 * j + 4] = bflo(w.z); v[8 * j + 5] = bfhi(w.z); v[8 * j + 6] = bflo(w.w); v[8 * j + 7] = bfhi(w.w); }
}
__device__ __forceinline__ void unpack8(const u32x4 w, float (&o)[8]) { o[0] = bflo(w.x); o[1] = bfhi(w.x); o[2] = bflo(w.y); o[3] = bfhi(w.y); o[4] = bflo(w.z); o[5] = bfhi(w.z); o[6] = bflo(w.w); o[7] = bfhi(w.w); }
namespace pg8 {
constexpr int BM = 256, BK = 64, HALF = 128, HTB = HALF * BK * 2, STAGE_BYTES = 8 * HTB, NXCD = 8, WGM = 8;
__host__ __device__ __forceinline__ int lds_byte(int r, int c) { const int st = (r >> 4) * 2 + (c >> 5), rr = r & 15, cc = c & 31, ob = rr * 64 + cc * 2; return st * 1024 + (ob ^ (((ob >> 9) & 1) << 5)); }
__host__ __device__ __forceinline__ void stage_rc(int b, int& R_, int& C_) { const int st = b / 1024, sb = b % 1024, swz = sb ^ (((sb >> 9) & 1) << 5); R_ = (st >> 1) * 16 + swz / 64; C_ = (st & 1) * 32 + (swz % 64) / 2; }
__host__ __device__ __forceinline__ int perm32(int rho) { const int n = rho >> 4, i = rho & 15; return 8 * (i >> 2) + 4 * n + (i & 3); }

struct Unit { int pm, pn, z; };
struct Gemm { int K, lda, ldb; };

__device__ __forceinline__ int xcd_remap(int L, int nwg) { const int q = nwg / NXCD, r = nwg % NXCD, xcd = L % NXCD, off = L / NXCD; return (xcd < r ? xcd * (q + 1) : r * (q + 1) + (xcd - r) * q) + off; }
__device__ __forceinline__ void tile_in_rect(int w, int nM, int nN, int& pm, int& pn) {
    const int nig = WGM * nN, gid = w / nig, fm = gid * WGM, gsz = (nM - fm) < WGM ? (nM - fm) : WGM;
    pm = fm + ((w % nig) % gsz); pn = (w % nig) / gsz;
}

#ifndef PG8_SP2
#define PG8_SP2 true
#endif
#ifndef PG8_ALIGN
#define PG8_ALIGN true
#endif
template <class Epi, class Sched, bool GATHER = false, bool ALIGN_EPI = PG8_ALIGN, bool SP2 = PG8_SP2>
__device__ __forceinline__ void gemm_phase(LAS unsigned char* lds, const Gemm g, const Sched& S, const Epi& E) {
    const int tid = threadIdx.x, wid = __builtin_amdgcn_readfirstlane(tid >> 6), lane = tid & 63, wr = wid >> 2, wc = wid & 3, fr = lane & 15, fq = lane >> 4;
    const int K = g.K, nt = K / BK;
    unsigned voffB[2]; int stR[2], stC[2];
#pragma unroll
    for (int i = 0; i < 2; ++i) { int R_, C_; stage_rc(tid * 16 + i * 8192, R_, C_); const int Rb = Epi::PERM ? (Epi::WIDE ? ((R_ >> 5) * 64 + perm32(R_ & 31)) : ((R_ & ~31) + perm32(R_ & 31))) : R_;
        stR[i] = R_; stC[i] = C_; voffB[i] = (unsigned)(Rb * g.ldb + C_) * 2u; }
    unsigned cvA[2][2], nvA[2][2];
    const size_t kstep = (size_t)(BK * 2);
    const size_t hstepB = (size_t)(Epi::WIDE ? 32 : HALF) * g.ldb * 2;
    const unsigned ldsw = (unsigned)wid * 1024u;
    const int aoff = lds_byte(wr * 64 + fr, fq * 8), boff = lds_byte(wc * 32 + fr, fq * 8);
#define PG8_SA(b, h) (((b) * 2 + (h)) * HTB)
#define PG8_SB(b, h) ((4 + (b) * 2 + (h)) * HTB)
#define PG8_STAGE(bufoff, gbase, voff) do { _Pragma("unroll") for (int _i = 0; _i < 2; ++_i) \
        __builtin_amdgcn_global_load_lds((const unsigned*)((const char*)(gbase) + (voff)[_i]), (LAS unsigned*)(lds + (bufoff) + ldsw + _i * 8192), 16, 0, 0); } while (0)
#define PG8_LDA(dst, b, h) do { _Pragma("unroll") for (int m = 0; m < 4; ++m) _Pragma("unroll") for (int k = 0; k < 2; ++k) dst[m][k] = *(const LAS bf16x8*)(lds + PG8_SA(b, h) + aoff + m * 2048 + k * 1024); } while (0)
#define PG8_LDB(dst, b, h) do { _Pragma("unroll") for (int n = 0; n < 2; ++n) _Pragma("unroll") for (int k = 0; k < 2; ++k) dst[n][k] = *(const LAS bf16x8*)(lds + PG8_SB(b, h) + boff + n * 2048 + k * 1024); } while (0)
#define PG8_MMA(ai, bj, At, Bt) do { __builtin_amdgcn_s_setprio(1); _Pragma("unroll") for (int m = 0; m < 4; ++m) _Pragma("unroll") for (int n = 0; n < 2; ++n) _Pragma("unroll") for (int k = 0; k < 2; ++k) \
        acc[ai][bj][m][n] = __builtin_amdgcn_mfma_f32_16x16x32_bf16(Bt[n][k], At[m][k], acc[ai][bj][m][n], 0, 0, 0); __builtin_amdgcn_s_setprio(0); } while (0)
#define PG8_WAIT_V(n) asm volatile("s_waitcnt vmcnt(" #n ")" ::: "memory")
#define PG8_WAIT_L(n) asm volatile("s_waitcnt lgkmcnt(" #n ")" ::: "memory")
#define PG8_BAR __builtin_amdgcn_s_barrier()
#define PG8_SCHED __builtin_amdgcn_sched_barrier(0)
    Unit cur, nxt; int ui = 0;
    if (!S.next(0, cur)) return;
    f32x4 acc[2][2][4][2];
#pragma unroll
    for (int a = 0; a < 2; ++a)
#pragma unroll
        for (int b = 0; b < 2; ++b)
#pragma unroll
            for (int m = 0; m < 4; ++m)
#pragma unroll
                for (int n = 0; n < 2; ++n) acc[a][b][m][n] = (f32x4){0.f, 0.f, 0.f, 0.f};
    bf16x8 At[4][2], B0[2][2], B1[2][2];
    const char* cA = S.aptr(cur); const char* cB = S.bptr(cur);
#define PG8_SETV(v, u) do { _Pragma("unroll") for (int h_ = 0; h_ < 2; ++h_) _Pragma("unroll") for (int i_ = 0; i_ < 2; ++i_) { \
        if constexpr (GATHER) { const int* mp_ = S.rowmap(u); (v)[h_][i_] = (unsigned)mp_[h_ * HALF + stR[i_]] * (unsigned)(g.lda * 2) + (unsigned)(stC[i_] * 2); } \
        else (v)[h_][i_] = (unsigned)((h_ * HALF + stR[i_]) * g.lda + stC[i_]) * 2u; } } while (0)
    PG8_SETV(cvA, cur);
    if constexpr (SP2) {
        PG8_STAGE(PG8_SB(0, 0), cB, voffB); PG8_STAGE(PG8_SB(0, 1), cB + hstepB, voffB); PG8_STAGE(PG8_SA(0, 0), cA, cvA[0]); PG8_STAGE(PG8_SA(0, 1), cA, cvA[1]);
        if (wr == 1) PG8_BAR;
        PG8_WAIT_V(2); PG8_BAR;
        PG8_STAGE(PG8_SB(1, 0), cB + kstep, voffB); PG8_STAGE(PG8_SA(1, 0), cA + kstep, cvA[0]); PG8_STAGE(PG8_SB(1, 1), cB + hstepB + kstep, voffB);
        PG8_WAIT_V(6); PG8_BAR;
    } else {
        PG8_STAGE(PG8_SB(0, 0), cB, voffB); PG8_STAGE(PG8_SA(0, 0), cA, cvA[0]); PG8_STAGE(PG8_SB(0, 1), cB + hstepB, voffB); PG8_STAGE(PG8_SA(0, 1), cA, cvA[1]);
        if (wr == 1) PG8_BAR;
        PG8_WAIT_V(4); PG8_BAR;
        PG8_STAGE(PG8_SB(1, 0), cB + kstep, voffB); PG8_STAGE(PG8_SA(1, 0), cA + kstep, cvA[0]); PG8_STAGE(PG8_SB(1, 1), cB + hstepB + kstep, voffB);
        PG8_WAIT_V(6); PG8_BAR;
    }
    for (;;) {
        const bool has_next = S.next(ui + 1, nxt);
        const char* nA = has_next ? S.aptr(nxt) : cA; const char* nB = has_next ? S.bptr(nxt) : cB;
        if constexpr (GATHER) { if (has_next) PG8_SETV(nvA, nxt); else {
#pragma unroll
            for (int h_ = 0; h_ < 2; ++h_) { nvA[h_][0] = cvA[h_][0]; nvA[h_][1] = cvA[h_][1]; } } }
        for (int t = 0; t < nt; t += 2) {
            const bool last = (t == nt - 2);
            const char* a1 = cA + (size_t)(t + 1) * kstep;
            const char* a2 = last ? nA : cA + (size_t)(t + 2) * kstep; const char* b2 = last ? nB : cB + (size_t)(t + 2) * kstep;
            const char* a3 = a2 + kstep; const char* b3 = b2 + kstep;
            unsigned va0[2], va1[2];
            if constexpr (GATHER) { va0[0] = last ? nvA[0][0] : cvA[0][0]; va0[1] = last ? nvA[0][1] : cvA[0][1]; va1[0] = last ? nvA[1][0] : cvA[1][0]; va1[1] = last ? nvA[1][1] : cvA[1][1]; }
            else { va0[0] = cvA[0][0]; va0[1] = cvA[0][1]; va1[0] = cvA[1][0]; va1[1] = cvA[1][1]; }
            if constexpr (SP2) {
            PG8_LDB(B0, 0, 0); PG8_LDB(B1, 0, 1); PG8_SCHED; PG8_LDA(At, 0, 0); PG8_STAGE(PG8_SA(1, 1), a1, cvA[1]);
            PG8_WAIT_V(8); PG8_WAIT_L(0); PG8_BAR; PG8_MMA(0, 0, At, B0); PG8_MMA(0, 1, At, B1); PG8_BAR; PG8_SCHED;
            PG8_LDA(At, 0, 1); PG8_STAGE(PG8_SB(0, 0), b2, voffB); PG8_STAGE(PG8_SB(0, 1), b2 + hstepB, voffB); PG8_STAGE(PG8_SA(0, 0), a2, va0);
            PG8_WAIT_V(8); PG8_WAIT_L(0); PG8_BAR; PG8_MMA(1, 0, At, B0); PG8_MMA(1, 1, At, B1); PG8_BAR; PG8_SCHED;
            PG8_LDB(B0, 1, 0); PG8_LDB(B1, 1, 1); PG8_SCHED; PG8_LDA(At, 1, 0); PG8_STAGE(PG8_SA(0, 1), a2, va1);
            PG8_WAIT_V(8); PG8_WAIT_L(0); PG8_BAR; PG8_MMA(0, 0, At, B0); PG8_MMA(0, 1, At, B1); PG8_BAR; PG8_SCHED;
            PG8_LDA(At, 1, 1); PG8_STAGE(PG8_SB(1, 0), b3, voffB); PG8_STAGE(PG8_SB(1, 1), b3 + hstepB, voffB); PG8_STAGE(PG8_SA(1, 0), a3, va0);
            PG8_WAIT_V(8); PG8_WAIT_L(0); PG8_BAR; PG8_MMA(1, 0, At, B0); PG8_MMA(1, 1, At, B1); PG8_BAR; PG8_SCHED;
            } else {
            PG8_LDB(B0, 0, 0); PG8_SCHED; PG8_LDA(At, 0, 0); PG8_STAGE(PG8_SA(1, 1), a1, cvA[1]);
            PG8_WAIT_L(8); PG8_BAR; PG8_WAIT_L(0); PG8_MMA(0, 0, At, B0); PG8_BAR; PG8_SCHED;
            PG8_LDB(B1, 0, 1); PG8_STAGE(PG8_SB(0, 0), b2, voffB);
            PG8_BAR; PG8_WAIT_L(0); PG8_MMA(0, 1, At, B1); PG8_BAR;
            PG8_LDA(At, 0, 1); PG8_STAGE(PG8_SA(0, 0), a2, va0);
            PG8_BAR; PG8_WAIT_L(0); PG8_MMA(1, 0, At, B0); PG8_BAR; PG8_SCHED;
            PG8_STAGE(PG8_SB(0, 1), b2 + hstepB, voffB);
            PG8_WAIT_V(6); PG8_BAR; PG8_MMA(1, 1, At, B1); PG8_BAR;
            PG8_LDB(B0, 1, 0); PG8_SCHED; PG8_LDA(At, 1, 0); PG8_STAGE(PG8_SA(0, 1), a2, va1);
            PG8_WAIT_L(8); PG8_BAR; PG8_WAIT_L(0); PG8_MMA(0, 0, At, B0); PG8_BAR; PG8_SCHED;
            PG8_LDB(B1, 1, 1); PG8_STAGE(PG8_SB(1, 0), b3, voffB);
            PG8_BAR; PG8_WAIT_L(0); PG8_MMA(0, 1, At, B1); PG8_BAR;
            PG8_LDA(At, 1, 1); PG8_STAGE(PG8_SA(1, 0), a3, va0);
            PG8_BAR; PG8_WAIT_L(0); PG8_MMA(1, 0, At, B0); PG8_BAR; PG8_SCHED;
            PG8_STAGE(PG8_SB(1, 1), b3 + hstepB, voffB);
            PG8_WAIT_V(6); PG8_BAR; PG8_MMA(1, 1, At, B1); PG8_BAR;
            }
        }
        if constexpr (ALIGN_EPI) { if (wr == 0) PG8_BAR; }
        E(acc, cur, wr, wc, fr, fq);
        if (!has_next) break;
#pragma unroll
        for (int a = 0; a < 2; ++a)
#pragma unroll
            for (int b = 0; b < 2; ++b)
#pragma unroll
                for (int m = 0; m < 4; ++m)
#pragma unroll
                    for (int n = 0; n < 2; ++n) acc[a][b][m][n] = (f32x4){0.f, 0.f, 0.f, 0.f};
        cur = nxt; cA = nA; cB = nB; ++ui;
        if constexpr (GATHER) {
#pragma unroll
            for (int h_ = 0; h_ < 2; ++h_) { cvA[h_][0] = nvA[h_][0]; cvA[h_][1] = nvA[h_][1]; } }
        if constexpr (ALIGN_EPI) { if (wr == 1) PG8_BAR; }
    }
    PG8_WAIT_V(0);
    if constexpr (!ALIGN_EPI) { if (wr == 0) PG8_BAR; }
    PG8_BAR;
#undef PG8_SETV
#undef PG8_SA
#undef PG8_SB
#undef PG8_STAGE
#undef PG8_LDA
#undef PG8_LDB
#undef PG8_MMA
#undef PG8_WAIT_V
#undef PG8_WAIT_L
#undef PG8_BAR
#undef PG8_SCHED
}

struct RectSched {
    const char* A; const char* Bt; size_t tsA, tsB; int nM, nN, nwg, G, c;
    __device__ __forceinline__ bool next(int i, Unit& u) const { const long L = (long)i * G + c; if (L >= nwg) return false; tile_in_rect(xcd_remap((int)L, nwg), nM, nN, u.pm, u.pn); u.z = 0; return true; }
    __device__ __forceinline__ const char* aptr(const Unit& u) const { return A + (size_t)u.pm * tsA; }
    __device__ __forceinline__ const char* bptr(const Unit& u) const { return Bt + (size_t)u.pn * tsB; }
};
struct TwoRectSched {
    const char* A0; const char* B0; const char* A1; const char* B1; size_t tsA, tsB; int nM0, nN0, nM1, nN1, pmoff1, pnoff1, G, c;
    __device__ __forceinline__ bool next(int i, Unit& u) const { const long L = (long)i * G + c; const int n0 = nM0 * nN0, n1 = nM1 * nN1; if (L >= n0 + n1) return false;
        if (L < n0) { tile_in_rect(xcd_remap((int)L, n0), nM0, nN0, u.pm, u.pn); u.z = 0; }
        else { tile_in_rect(xcd_remap((int)L - n0, n1), nM1, nN1, u.pm, u.pn); u.pm += pmoff1; u.pn += pnoff1; u.z = 1; }
        return true; }
    __device__ __forceinline__ const char* aptr(const Unit& u) const { return u.z ? A1 + (size_t)(u.pm - pmoff1) * tsA : A0 + (size_t)u.pm * tsA; }
    __device__ __forceinline__ const char* bptr(const Unit& u) const { return u.z ? B1 + (size_t)(u.pn - pnoff1) * tsB : B0 + (size_t)u.pn * tsB; }
};
struct GroupSched {
    const char* A; const char* Bt; size_t tsA, tsB; int tM, tN, nE, G, c; const int* map;
    __device__ __forceinline__ const int* rowmap(const Unit& u) const { return map + u.pm * 256; }
    __device__ __forceinline__ bool next(int i, Unit& u) const { const int per = tM * tN, nwg = per * nE; const long L = (long)i * G + c; if (L >= nwg) return false;
        const int w = xcd_remap((int)L, nwg), e = w / per; int pm, pn; tile_in_rect(w % per, tM, tN, pm, pn); u.pm = e * tM + pm; u.pn = e * tN + pn; u.z = e; return true; }
    __device__ __forceinline__ const char* aptr(const Unit& u) const { return map ? A : A + (size_t)u.pm * tsA; }
    __device__ __forceinline__ const char* bptr(const Unit& u) const { return Bt + (size_t)u.pn * tsB; }
};
}
#define XB_TMO      128
#define XB_XCNT(j)  (256  + 64 * (j))
#define XB_XSUB(j)  (1280 + 64 * (j))
#define XB_XGEN(j)  (2304 + 64 * (j))
#define XB_TOP      3328
#define XB_TOPGEN   3392
#define XCD_BAR_WORDS 3456
#define XB_SPIN_CAP (1u << 20)

__device__ __forceinline__ unsigned xb_ld(unsigned* p)              { return __hip_atomic_load(p, __ATOMIC_RELAXED, __HIP_MEMORY_SCOPE_AGENT); }
__device__ __forceinline__ unsigned xb_add(unsigned* p, unsigned v) { return __hip_atomic_fetch_add(p, v, __ATOMIC_RELAXED, __HIP_MEMORY_SCOPE_AGENT); }
__device__ __forceinline__ unsigned xb_xcc_id() { return (unsigned)__builtin_amdgcn_s_getreg((3 << 11) | 20) & 0xFu; }
#ifndef XB_SLEEP
#define XB_SLEEP 0
#endif
#define XB_SPIN(cond, bar) do { unsigned _sp = 0; while (cond) { if (XB_SLEEP) __builtin_amdgcn_s_sleep(1); \
    if ((++_sp & 255u) == 0u) { if (xb_ld(&(bar)[XB_TMO])) break; if (_sp > XB_SPIN_CAP) { atomicAdd(&(bar)[XB_TMO], 1u); break; } } } } while (0)

struct XcdBarrier { unsigned* bar; unsigned x; volatile LAS unsigned* st; };

__device__ __forceinline__ XcdBarrier xcd_barrier_post(unsigned* bar, volatile LAS unsigned* st) {
    XcdBarrier b; b.bar = bar; b.x = xb_xcc_id(); b.st = st;
    if (threadIdx.x == 0) (void)xb_add(&bar[XB_XCNT(b.x)], 1u);
    return b;
}
__device__ __forceinline__ void xcd_barrier_complete(unsigned* bar, unsigned x, unsigned& nloc, unsigned& nx) {
    const unsigned G = gridDim.x * gridDim.y * gridDim.z;
    unsigned sum, cnt, mine, sp = 0u;
    for (;;) {
        sum = 0u; cnt = 0u; mine = 0u;
#pragma unroll
        for (unsigned j = 0; j < 16; ++j) { const unsigned c = xb_ld(&bar[XB_XCNT(j)]); sum += c; cnt += (c > 0u) ? 1u : 0u; mine = (j == x) ? c : mine; }
        if (sum == G) break;
        __builtin_amdgcn_s_sleep(1);
        if ((++sp & 255u) == 0u) { if (xb_ld(&bar[XB_TMO])) break; if (sp > XB_SPIN_CAP) { atomicAdd(&bar[XB_TMO], 1u); break; } }
    }
    nloc = mine > 0u ? mine : 1u; nx = cnt > 0u ? cnt : 1u;
}
__device__ __forceinline__ void xcd_barrier(const XcdBarrier& b) {
    asm volatile("s_waitcnt vmcnt(0)" ::: "memory");
    __syncthreads();
    if (threadIdx.x == 0) {
        unsigned* bar = b.bar;
        __builtin_amdgcn_s_waitcnt(0);
        unsigned nloc = b.st[0], nx = b.st[1];
        if (nloc == 0u) { xcd_barrier_complete(bar, b.x, nloc, nx); b.st[0] = nloc; b.st[1] = nx; }
        const unsigned old = xb_add(&bar[XB_XSUB(b.x)], 1u);
        const unsigned gen = old / nloc;
        if (old + 1u == (gen + 1u) * nloc) {
            __builtin_amdgcn_fence(__ATOMIC_RELEASE, "agent");
            asm volatile("s_waitcnt vmcnt(0)" ::: "memory");
            const unsigned og = xb_add(&bar[XB_TOP], 1u);
            const unsigned tg = og / nx;
            if (og + 1u == (tg + 1u) * nx) xb_add(&bar[XB_TOPGEN], 1u);
            else XB_SPIN(xb_ld(&bar[XB_TOPGEN]) == tg, bar);
            __builtin_amdgcn_fence(__ATOMIC_ACQUIRE, "agent");
            xb_add(&bar[XB_XGEN(b.x)], 1u);
            asm volatile("s_waitcnt vmcnt(0)" ::: "memory");
        } else {
            XB_SPIN(xb_ld(&bar[XB_XGEN(b.x)]) == gen, bar);
            __builtin_amdgcn_fence(__ATOMIC_ACQUIRE, "agent");
            asm volatile("s_waitcnt vmcnt(0)" ::: "memory");
        }
    }
    __syncthreads();
}
constexpr size_t al256(size_t x) { return (x + 255) / 256 * 256; }
constexpr size_t WS_CTL = 0, CTL_BYTES = 1u << 20;
constexpr size_t WS_WEV = WS_CTL + CTL_BYTES;
constexpr size_t WS_WOD = WS_WEV + (size_t)EVN * D * 2;
constexpr size_t WS_WO  = WS_WOD + (size_t)ODN * D * 2;
constexpr size_t WS_WQ  = WS_WO + (size_t)2 * D * D * 2;
constexpr size_t WS_WKV = WS_WQ + (size_t)1536 * 512 * 2;
constexpr size_t WS_WL  = WS_WKV + (size_t)2048 * 512 * 2;
constexpr size_t WS_WGU = WS_WL + (size_t)32 * 128 * 128 * 2;
constexpr size_t WS_WDN = WS_WGU + (size_t)2 * NE * GUN * D * 2;
constexpr size_t WS_MODP = WS_WDN + (size_t)2 * NE * D * FF * 2;
constexpr size_t WS_MOD = WS_MODP + (size_t)2 * MODS * 5 * 12288 * 4;
constexpr size_t WS_ROPE = WS_MOD + (size_t)2 * 5 * 12288 * 4;
constexpr size_t WS_LB = WS_ROPE + (size_t)4096 * 64 * 4;
constexpr size_t WS_XA = al256(WS_LB + 2 * 1024 * 4);
constexpr size_t WS_X1B = WS_XA + (size_t)R * D * 2;
constexpr size_t WS_H = WS_XA + (size_t)R * D * 4;
constexpr size_t WS_Y = WS_H + (size_t)(R + 1) * D * 2;
constexpr size_t WS_BIG = WS_Y + (size_t)R * D * 2;
constexpr size_t WS_U0 = WS_BIG;
constexpr size_t WS_OD = WS_U0 + (size_t)R * EVN * 2;
constexpr size_t WS_HD = WS_OD + (size_t)2 * R * 1024 * 2;
constexpr size_t WS_LA = WS_HD + (size_t)2 * R * 1024 * 2;
constexpr size_t WS_BB = WS_LA + (size_t)2 * R * 1024 * 2;
constexpr size_t WS_BIG_END0 = WS_BB + (size_t)2 * R * 1024 * 2;
constexpr size_t WS_DELTA = WS_BIG + ((size_t)300 << 20);
static_assert(WS_DELTA + (size_t)R * D * 2 <= WS_BIG_END0, "delta");
constexpr int MROWS0 = 2304, MROWS1 = 2048;
constexpr size_t WS_HID = WS_BIG;
constexpr size_t WS_YE = WS_HID + (size_t)NE * MROWS0 * FF * 2;
constexpr size_t WS_AFFL = WS_YE + (size_t)NE * MROWS0 * D * 2;
constexpr size_t WS_AFFC = WS_AFFL + (size_t)NB * NE * TL * 4;
constexpr size_t WS_ROWMAP = WS_AFFC + (size_t)NB * NE * TC * 4;
constexpr size_t WS_IDXC = WS_ROWMAP + (size_t)NE * MROWS0 * 4;
constexpr size_t WS_GATL = WS_IDXC + (size_t)NB * NE * CAPC * 4;
constexpr size_t WS_GATC = WS_GATL + (size_t)NB * NE * CAPL * 4;
constexpr size_t WS_POS = WS_GATC + (size_t)NB * NE * CAPC * 4;
constexpr size_t WS_GROW = WS_POS + (size_t)R * NE * 4;
constexpr size_t WS_BIG_ENDM = WS_GROW + (size_t)NE * MROWS0 * 4;
static_assert(WS_BIG_ENDM <= WS_DELTA, "delta vs MoE view");
constexpr size_t WS_U1 = WS_BIG;
constexpr size_t WS_Q = WS_U1 + (size_t)R * ODN * 2;
constexpr size_t WS_KF = WS_Q + (size_t)NB * 8 * TL * 192 * 2;
constexpr size_t WS_VF = WS_KF + (size_t)NB * 8 * KSEQ * 192 * 2;
constexpr size_t WS_XBC = WS_VF + (size_t)NB * 8 * KSEQ * 128 * 2;
constexpr size_t WS_DT = WS_XBC + (size_t)R * 1536 * 4;
constexpr size_t WS_RINV = WS_DT + (size_t)R * 32 * 4;
constexpr size_t WS_YS = WS_RINV + (size_t)2 * R * 4;
constexpr size_t WS_BIG_END1 = WS_YS + (size_t)2 * RL * 1024 * 2;
constexpr size_t cmax(size_t a, size_t b) { return a > b ? a : b; }
constexpr size_t WS_END = al256(cmax(WS_BIG_END0, cmax(WS_BIG_ENDM, WS_BIG_END1)));

constexpr int LDS_SCRATCH = 131072;
constexpr int LDS_MISC = LDS_SCRATCH;
constexpr int LDS_XTRA = LDS_MISC + 256;
constexpr int LDS_BYTES = 151552;

struct Params { const float* in[35]; float* out; unsigned char* ws; int ph_lo, ph_hi; };
enum In { I_X = 0, I_C, I_CTX, I_CCTX, I_WMOD, I_BMOD, I_NMIX, I_NFFN, I_WOUT, I_EVW, I_HGLB, I_HGON, I_LCW, I_LCB, I_LWA, I_LBA, I_LWX, I_LBX, I_LLAM,
          I_ODW, I_QN, I_WQU, I_KVN, I_WKVU, I_SCW, I_SCB, I_SDTB, I_SALOG, I_SD, I_SON, I_ROUT, I_WG, I_WU, I_WD, I_FN };

struct Frame {
    LAS unsigned char* lds;
    const float* const* in; float* out; unsigned char* ws;
    int tid, lane, wave, bid, G;
    template <class T> __device__ __forceinline__ T* w(size_t off) const { return (T*)(ws + off); }
    __device__ __forceinline__ int gw() const { return bid * NWAVES + wave; }
    __device__ __forceinline__ int ngw() const { return G * NWAVES; }
};
__device__ __forceinline__ int row_bsel(int r) { return r < RL ? (r >> 12) : 4; }
__device__ __forceinline__ const float* mod_ptr(const Frame& F, int l, int bsel, int chunk) { return F.w<const float>(WS_MOD) + ((size_t)(l * 5 + bsel) * 6 + chunk) * 2048; }
#ifndef PRO_DUP_MODP
#define PRO_DUP_MODP 1
#endif
template <bool SC>
__device__ __forceinline__ void tr_item(const float* W, int ldsrc, int srccol, const float* kscale, bf16_t* WT, int K, int k0, int n0, LAS float* scr, int lane) {
    float v[32]; const int sc_ = srccol >= 0 ? srccol : 0; const float* Wp = W + (size_t)(k0 + (lane >> 5)) * ldsrc + sc_;
#pragma unroll
    for (int i = 0; i < 32; ++i) v[i] = Wp[(size_t)(2 * i) * ldsrc];
    if constexpr (SC) { float ks[32]; const float* kp = kscale + k0 + (lane >> 5);
#pragma unroll
        for (int i = 0; i < 32; ++i) ks[i] = kp[2 * i];
#pragma unroll
        for (int i = 0; i < 32; ++i) v[i] *= ks[i]; }
    const float keep = srccol >= 0 ? 1.0f : 0.0f;
#pragma unroll
    for (int i = 0; i < 32; ++i) scr[(2 * i + (lane >> 5)) * 33 + (lane & 31)] = v[i] * keep;
    LDS_WAIT(); asm volatile("" ::: "memory");
    const int c = lane & 7;
#pragma unroll
    for (int j = 0; j < 4; ++j) { const int n = (lane >> 3) + 8 * j; const LAS float* s = scr + (8 * c) * 33 + n;
        u32x4 o; o.x = pk2(s[0 * 33], s[1 * 33]); o.y = pk2(s[2 * 33], s[3 * 33]); o.z = pk2(s[4 * 33], s[5 * 33]); o.w = pk2(s[6 * 33], s[7 * 33]);
        *(u32x4*)(WT + (size_t)(n0 + n) * K + k0 + 8 * c) = o; }
    LDS_WAIT(); asm volatile("" ::: "memory");
}
__device__ __forceinline__ int od_map(int n) {
    if (n < 2048) return n;
    if (n < 3584) return n + 64;
    if (n < 3648) { const int j = n - 3584; return 2048 + (j >> 1) + 32 * (j & 1); }
    if (n < 3680) return n;
    return -1;
}
__device__ __forceinline__ int qup_map(int n) { const int h = n / 192, dd = n % 192; if (dd < 128) return n; const int j = dd - 128; return h * 192 + 128 + (j >> 1) + 32 * (j & 1); }

constexpr int IT_GU = NE * 32 * 88, IT_DN = NE * 22 * 64, IT_MOE = IT_GU + IT_DN;
struct MoeItem { const float* src; bf16_t* dst; int ldsrc, K; };
__device__ __forceinline__ MoeItem moe_item_desc(const Frame& F, int l, int it) {
    MoeItem m;
    if (it < IT_GU) { const int e = it / (32 * 88), r = it % (32 * 88), kb = r / 88, nb = r % 88, n0 = nb * 32, j = n0 >> 8, rr = n0 & 255;
        m.src = (rr < 128 ? F.in[I_WG] : F.in[I_WU]) + (size_t)(l * NE + e) * D * FF + (size_t)(kb * 64 + (F.lane >> 5)) * FF + 128 * j + (rr & 127) + (F.lane & 31); m.ldsrc = FF; m.K = D;
        m.dst = F.w<bf16_t>(WS_WGU) + ((size_t)(l * NE + e) * GUN + n0) * D + kb * 64;
    } else { it -= IT_GU; const int e = it / (22 * 64), r = it % (22 * 64), kb = r / 64, nb = r % 64;
        m.src = F.in[I_WD] + (size_t)(l * NE + e) * FF * D + (size_t)(kb * 64 + (F.lane >> 5)) * D + nb * 32 + (F.lane & 31); m.ldsrc = D; m.K = FF;
        m.dst = F.w<bf16_t>(WS_WDN) + ((size_t)(l * NE + e) * D + nb * 32) * FF + kb * 64;
    }
    return m;
}
__device__ __forceinline__ void moe_item_load(const MoeItem& m, float (&v)[32]) {
#pragma unroll
    for (int i = 0; i < 32; ++i) v[i] = __builtin_nontemporal_load(m.src + (size_t)(2 * i) * m.ldsrc);
}
__device__ __forceinline__ void moe_item_finish(const MoeItem& m, const float (&v)[32], LAS float* scr, int lane) {
#pragma unroll
    for (int i = 0; i < 32; ++i) scr[(2 * i + (lane >> 5)) * 33 + (lane & 31)] = v[i];
    LDS_WAIT(); asm volatile("" ::: "memory");
    const int c = lane & 7;
#pragma unroll
    for (int j = 0; j < 4; ++j) { const int n = (lane >> 3) + 8 * j; const LAS float* s = scr + (8 * c) * 33 + n;
        u32x4 o; o.x = pk2c(s[0 * 33], s[1 * 33]); o.y = pk2c(s[2 * 33], s[3 * 33]); o.z = pk2c(s[4 * 33], s[5 * 33]); o.w = pk2c(s[6 * 33], s[7 * 33]);
        __builtin_nontemporal_store(o, (u32x4*)(m.dst + (size_t)n * m.K + 8 * c)); }
    LDS_WAIT(); asm volatile("" ::: "memory");
}
#ifndef HC_PLLO
#define HC_PLLO 59648
#endif
constexpr int PL_LO = HC_PLLO;
static_assert(PL_LO <= IT_MOE, "plan");
__device__ __forceinline__ void moe_convert_range(const Frame& F, int l, int lo, int hi, int first, int stride) {
    LAS float* scr = (LAS float*)(F.lds + F.wave * 8448);
    int it = lo + first; if (it >= hi) return;
    MoeItem mA = moe_item_desc(F, l, it), mB = mA; float vA[32], vB[32];
    moe_item_load(mA, vA);
#pragma unroll 1
    for (;;) {
        it += stride; const bool hb = it < hi;
        if (hb) { mB = moe_item_desc(F, l, it); moe_item_load(mB, vB); }
        moe_item_finish(mA, vA, scr, F.lane);
        if (!hb) break;
        it += stride; const bool ha = it < hi;
        if (ha) { mA = moe_item_desc(F, l, it); moe_item_load(mA, vA); }
        moe_item_finish(mB, vB, scr, F.lane);
        if (!ha) break;
    }
}

__device__ __forceinline__ void phase_prologue(const Frame& F) {
    LAS float* scr = (LAS float*)(F.lds + F.wave * 8448);
    const int gw = F.gw(), ngw = F.ngw();
    constexpr int IT_EV = 32 * (EVN / 32), IT_OD = 32 * (ODN / 32), IT_WO = 2 * 32 * 64, IT_Q = 8 * 48, IT_KV = 8 * 64, IT_L = 32 * 8;
    constexpr int IT_MODP = 2 * MODS * 48, IT_ROPE = 2048, IT_LB = 32;
    constexpr int NIT = IT_EV + IT_OD + IT_WO + IT_Q + IT_KV + IT_L + IT_MODP + IT_ROPE + IT_LB;
    for (int it0 = gw; it0 < NIT; it0 += ngw) {
        int it = it0;
        if (it < IT_MODP) {
            const int l = it / (MODS * 48), s = (it / 48) % MODS, cb = it % 48, n = cb * 256 + 4 * F.lane, k0 = s * 64;
            float scv[5];
#pragma unroll
            for (int j = 0; j < 5; ++j) scv[j] = siluf_(j < 4 ? F.in[I_C][j * 2048 + k0 + F.lane] : F.in[I_CCTX][k0 + F.lane]);
            const float* W = F.in[I_WMOD] + (size_t)l * D * 12288 + (size_t)k0 * 12288 + n;
            f32x4 acc5[5];
#pragma unroll 1
            for (int rr_ = 0; rr_ < PRO_DUP_MODP; ++rr_) {
#pragma unroll
            for (int j = 0; j < 5; ++j) acc5[j] = (f32x4){0.f, 0.f, 0.f, 0.f};
#pragma unroll 16
            for (int k = 0; k < 64; ++k) { const f32x4 w = *(const f32x4*)(W + (size_t)k * 12288);
#pragma unroll
                for (int j = 0; j < 5; ++j) { const float sc = __int_as_float(__builtin_amdgcn_readlane(__float_as_int(scv[j]), k)); acc5[j] += w * sc; } }
            asm volatile("" ::: "memory"); }
            float* o = F.w<float>(WS_MODP) + ((size_t)(l * MODS + s) * 5) * 12288 + n;
#pragma unroll
            for (int j = 0; j < 5; ++j) *(f32x4*)(o + (size_t)j * 12288) = acc5[j];
            continue; }
        it -= IT_MODP;
        if (it < IT_EV) { const int nblk = EVN / 32, kb = it / nblk, nb = it % nblk; tr_item<false>(F.in[I_EVW], EVN, nb * 32 + (F.lane & 31), nullptr, F.w<bf16_t>(WS_WEV), D, kb * 64, nb * 32, scr, F.lane); continue; }
        it -= IT_EV;
        if (it < IT_OD) { const int nblk = ODN / 32, kb = it / nblk, nb = it % nblk; tr_item<false>(F.in[I_ODW], ODSRC, od_map(nb * 32 + (F.lane & 31)), nullptr, F.w<bf16_t>(WS_WOD), D, kb * 64, nb * 32, scr, F.lane); continue; }
        it -= IT_OD;
        if (it < IT_WO) { const int l = it / (32 * 64), r = it % (32 * 64), kb = r / 64, nb = r % 64; tr_item<false>(F.in[I_WOUT] + (size_t)l * D * D, D, nb * 32 + (F.lane & 31), nullptr, F.w<bf16_t>(WS_WO) + (size_t)l * D * D, D, kb * 64, nb * 32, scr, F.lane); continue; }
        it -= IT_WO;
        if (it < IT_Q) { const int kb = it / 48, nb = it % 48; tr_item<true>(F.in[I_WQU], 1536, qup_map(nb * 32 + (F.lane & 31)), F.in[I_QN], F.w<bf16_t>(WS_WQ), 512, kb * 64, nb * 32, scr, F.lane); continue; }
        it -= IT_Q;
        if (it < IT_KV) { const int kb = it / 64, nb = it % 64; tr_item<true>(F.in[I_WKVU], 2048, nb * 32 + (F.lane & 31), F.in[I_KVN], F.w<bf16_t>(WS_WKV), 512, kb * 64, nb * 32, scr, F.lane); continue; }
        it -= IT_KV;
        if (it < IT_L) { const int mat = it / 8, r = it % 8, kb = r / 4, nb = r % 4, d = mat >> 4, ax = (mat >> 3) & 1, hb = mat & 7;
            const float* src = (ax ? F.in[I_LWX] : F.in[I_LWA]) + (size_t)(d * 8 + hb) * 128 * 128;
            tr_item<false>(src, 128, nb * 32 + (F.lane & 31), nullptr, F.w<bf16_t>(WS_WL) + (size_t)mat * 128 * 128, 128, kb * 64, nb * 32, scr, F.lane); continue; }
        it -= IT_L;
        if (it < IT_ROPE) {
            const int idx = it * 64 + F.lane, t = idx >> 5, i = idx & 31;
            const float inv = exp2f(-(float)(i & 15) * 0.8304820237218406f);
            const float pos = (i < 16) ? (float)(t >> 6) : (float)(t & 63);
            float rev = (pos * inv) * 0.15915494309189535f; rev -= floorf(rev);
            F.w<f32x2>(WS_ROPE)[idx] = (f32x2){__builtin_amdgcn_cosf(rev), __builtin_amdgcn_sinf(rev)};
            continue; }
        it -= IT_ROPE;
        { const int idx = it * 64 + F.lane, d = idx >> 10, k = idx & 1023;
          const float a0 = F.in[I_HGLB][d * 2048 + k], a1 = F.in[I_HGLB][d * 2048 + 1024 + k];
          F.w<float>(WS_LB)[idx] = 1.0f / (1.0f + expf(a1 - a0)); }
    }
    moe_convert_range(F, 0, F.G == 256 ? PL_LO : 0, IT_MOE, gw, ngw);
}

template <class FSc, class FSh>
__device__ __forceinline__ void norm_mod_row(const float (&v)[32], const float* nw, FSc sc, FSh sh, bf16_t* orow, int lane) {
    float ss = 0.f;
#pragma unroll
    for (int i = 0; i < 32; ++i) ss += v[i] * v[i];
    const float rinv = rsqrtf(wave_sum(ss) * (1.0f / D) + EPS);
    float o[32];
#pragma unroll
    for (int j = 0; j < 4; ++j)
#pragma unroll
        for (int q = 0; q < 8; ++q) { const int d = (j * 64 + lane) * 8 + q; o[8 * j + q] = v[8 * j + q] * rinv * nw[d] * (1.0f + sc(d)) + sh(d); }
    store_row_bf16(orow, lane, o);
}
__device__ __forceinline__ const float* x_in_row(const Frame& F, int r) { return r < RL ? F.in[I_X] + (size_t)r * D : F.in[I_CTX] + (size_t)(r - RL) * D; }

__device__ __forceinline__ void phase_norm0(const Frame& F) {
    for (int i = F.bid * NTHR + F.tid; i < 2 * 5 * 12288; i += F.G * NTHR) { const int l = i / (5 * 12288), rem = i % (5 * 12288), j = rem / 12288, n = rem % 12288;
        float a = F.in[I_BMOD][l * 12288 + n]; const float* p = F.w<const float>(WS_MODP) + ((size_t)(l * MODS) * 5 + j) * 12288 + n;
#pragma unroll
        for (int s = 0; s < MODS; ++s) a += p[(size_t)s * 5 * 12288];
        F.w<float>(WS_MOD)[i] = a; }
    if (F.bid == 0) for (int i = F.tid; i < D / 2; i += NTHR) ((unsigned*)(F.w<bf16_t>(WS_H) + (size_t)R * D))[i] = 0u;
    LAS float* SH = (LAS float*)F.lds; LAS float* SCL = SH + 2048;
    const int per = (R + F.G - 1) / F.G, r0 = F.bid * per, r1 = (r0 + per < R) ? r0 + per : R;
    int cur = -1;
    for (int rb = r0; rb < r1; rb += NWAVES) {
        const int r = rb + F.wave;
        const int bs_first = row_bsel(rb), bs_last = row_bsel((rb + NWAVES - 1 < r1 ? rb + NWAVES - 1 : r1 - 1));
        for (int pass = 0; pass < (bs_first == bs_last ? 1 : 2); ++pass) {
            const int bs = pass == 0 ? bs_first : bs_last;
            if (bs != cur) {
                __syncthreads();
                for (int i = F.tid; i < 4096; i += NTHR) { const int n = i;
                    float a = F.in[I_BMOD][n]; const float* p = F.w<const float>(WS_MODP) + ((size_t)bs) * 12288 + n;
#pragma unroll
                    for (int s = 0; s < MODS; ++s) a += p[(size_t)s * 5 * 12288];
                    SH[i] = a; }
                __syncthreads();
                cur = bs;
            }
            if (r < r1 && row_bsel(r) == bs) {
                float v[32]; load_row_f32(x_in_row(F, r), F.lane, v);
                norm_mod_row(v, F.in[I_NMIX], [&](int d) { return SCL[d]; }, [&](int d) { return SH[d]; }, F.w<bf16_t>(WS_H) + (size_t)r * D, F.lane);
            }
        }
    }
}
typedef f32x4 AccT[2][2][4][2];
#ifndef EPI_WIDE
#define EPI_WIDE 1
#endif
constexpr int CW = EPI_WIDE ? 64 : 32, CBJ = EPI_WIDE ? 32 : 128;

struct EpiStoreBf16 {
    static constexpr bool PERM = true, WIDE = EPI_WIDE;
    bf16_t* O; int ldc;
    __device__ __forceinline__ void operator()(const AccT& acc, const pg8::Unit& u, int wr, int wc, int fr, int fq) const {
        const int row0 = u.pm * 256 + wr * 64 + fr, col0 = u.pn * 256 + wc * CW + 8 * fq;
#pragma unroll
        for (int ai = 0; ai < 2; ++ai)
#pragma unroll
            for (int m = 0; m < 4; ++m) { bf16_t* rowp = O + (size_t)(row0 + ai * 128 + m * 16) * ldc + col0;
#pragma unroll
                for (int bj = 0; bj < 2; ++bj) { const f32x4 v0 = acc[ai][bj][m][0], v1 = acc[ai][bj][m][1];
                    u32x4 w; w.x = pk2c(v0[0], v0[1]); w.y = pk2c(v0[2], v0[3]); w.z = pk2c(v1[0], v1[1]); w.w = pk2c(v1[2], v1[3]);
                    *(u32x4*)(rowp + bj * CBJ) = w; } }
    }
};
struct EpiEv {
    static constexpr bool PERM = true, WIDE = EPI_WIDE;
    bf16_t* O; const float* LB;
    __device__ __forceinline__ void operator()(const AccT& acc, const pg8::Unit& u, int wr, int wc, int fr, int fq) const {
        const int row0 = u.pm * 256 + wr * 64 + fr, col0 = u.pn * 256 + wc * CW + 8 * fq;
        const int mode = (u.pn < 4) ? 1 : ((u.pn >= 12 && u.pn < 20) ? 2 : 0);
        f32x4 lbv[2][2];
        if (mode == 2) {
#pragma unroll
            for (int bj = 0; bj < 2; ++bj) { lbv[bj][0] = *(const f32x4*)(LB + col0 - 3072 + bj * CBJ); lbv[bj][1] = *(const f32x4*)(LB + col0 - 3072 + bj * CBJ + 4); } }
#pragma unroll
        for (int ai = 0; ai < 2; ++ai)
#pragma unroll
            for (int m = 0; m < 4; ++m) { bf16_t* rowp = O + (size_t)(row0 + ai * 128 + m * 16) * EVN + col0;
#pragma unroll
                for (int bj = 0; bj < 2; ++bj) { f32x4 v0 = acc[ai][bj][m][0], v1 = acc[ai][bj][m][1];
                    if (mode == 1) {
#pragma unroll
                        for (int q = 0; q < 4; ++q) { v0[q] = siluf_(v0[q]); v1[q] = siluf_(v1[q]); } }
                    else if (mode == 2) {
#pragma unroll
                        for (int q = 0; q < 4; ++q) { const float l0 = lbv[bj][0][q], l1 = lbv[bj][1][q];
                            v0[q] = __builtin_amdgcn_logf(l0 + (1.0f - l0) * sigmoidf_(v0[q])); v1[q] = __builtin_amdgcn_logf(l1 + (1.0f - l1) * sigmoidf_(v1[q])); } }
                    u32x4 w; w.x = pk2c(v0[0], v0[1]); w.y = pk2c(v0[2], v0[3]); w.z = pk2c(v1[0], v1[1]); w.w = pk2c(v1[2], v1[3]);
                    *(u32x4*)(rowp + bj * CBJ) = w; } }
    }
};
struct EpiDelta {
    static constexpr bool PERM = true, WIDE = EPI_WIDE;
    bf16_t* O; const float* mod;
    __device__ __forceinline__ void operator()(const AccT& acc, const pg8::Unit& u, int wr, int wc, int fr, int fq) const {
        const int row0 = u.pm * 256 + wr * 64 + fr, col0 = u.pn * 256 + wc * CW + 8 * fq;
        const float* g = mod + (size_t)(row_bsel(u.pm * 256) * 6 + 2) * 2048 + col0;
        f32x4 gv[2][2];
#pragma unroll
        for (int bj = 0; bj < 2; ++bj) { gv[bj][0] = *(const f32x4*)(g + bj * CBJ); gv[bj][1] = *(const f32x4*)(g + bj * CBJ + 4); }
        asm volatile("" : "+v"(gv[0][0]), "+v"(gv[0][1]), "+v"(gv[1][0]), "+v"(gv[1][1]) :: "memory");
#pragma unroll
        for (int ai = 0; ai < 2; ++ai)
#pragma unroll
            for (int m = 0; m < 4; ++m) { bf16_t* rowp = O + (size_t)(row0 + ai * 128 + m * 16) * D + col0;
#pragma unroll
                for (int bj = 0; bj < 2; ++bj) { const f32x4 v0 = acc[ai][bj][m][0] * gv[bj][0], v1 = acc[ai][bj][m][1] * gv[bj][1];
                    u32x4 w; w.x = pk2c(v0[0], v0[1]); w.y = pk2c(v0[2], v0[3]); w.z = pk2c(v1[0], v1[1]); w.w = pk2c(v1[2], v1[3]);
                    *(u32x4*)(rowp + bj * CBJ) = w; } }
    }
};
struct EpiResid {
    static constexpr bool PERM = false, WIDE = false;
    const float* xin; const float* cin; float* XA; const float* mod;
    __device__ __forceinline__ void operator()(const AccT& acc, const pg8::Unit& u, int wr, int wc, int fr, int fq) const {
        const int row0 = u.pm * 256 + wr * 64 + fr, col0 = u.pn * 256 + wc * 32 + 4 * fq;
        const int bsel = row_bsel(u.pm * 256);
        const float* g = mod + (size_t)(bsel * 6 + 2) * 2048;
        f32x4 gv[2][2];
#pragma unroll
        for (int bj = 0; bj < 2; ++bj)
#pragma unroll
            for (int n = 0; n < 2; ++n) gv[bj][n] = *(const f32x4*)(g + col0 + bj * 128 + n * 16);
#pragma unroll
        for (int ai = 0; ai < 2; ++ai)
#pragma unroll
            for (int m = 0; m < 4; ++m) { const int r = row0 + ai * 128 + m * 16;
                const float* bp = xin ? (r < RL ? xin + (size_t)r * D : cin + (size_t)(r - RL) * D) : XA + (size_t)r * D;
                float* op = XA + (size_t)r * D;
#pragma unroll
                for (int bj = 0; bj < 2; ++bj)
#pragma unroll
                    for (int n = 0; n < 2; ++n) { const int c = col0 + bj * 128 + n * 16; const f32x4 b = *(const f32x4*)(bp + c); *(f32x4*)(op + c) = b + gv[bj][n] * acc[ai][bj][m][n]; } }
    }
};
struct EpiGateUp {
    static constexpr bool PERM = true, WIDE = false;
    bf16_t* HID;
    __device__ __forceinline__ void operator()(const AccT& acc, const pg8::Unit& u, int wr, int wc, int fr, int fq) const {
        const int row0 = u.pm * 256 + wr * 64 + fr, j = u.pn % 11, col0 = j * 128 + wc * 32 + 8 * fq;
#pragma unroll
        for (int ai = 0; ai < 2; ++ai)
#pragma unroll
            for (int m = 0; m < 4; ++m) { bf16_t* rowp = HID + (size_t)(row0 + ai * 128 + m * 16) * FF + col0;
                const f32x4 g0 = acc[ai][0][m][0], g1 = acc[ai][0][m][1], u0 = acc[ai][1][m][0], u1 = acc[ai][1][m][1];
                u32x4 w; w.x = pk2c(siluf_(g0[0]) * u0[0], siluf_(g0[1]) * u0[1]); w.y = pk2c(siluf_(g0[2]) * u0[2], siluf_(g0[3]) * u0[3]);
                w.z = pk2c(siluf_(g1[0]) * u1[0], siluf_(g1[1]) * u1[1]); w.w = pk2c(siluf_(g1[2]) * u1[2], siluf_(g1[3]) * u1[3]);
                *(u32x4*)rowp = w; }
    }
};
struct EpiDown {
    static constexpr bool PERM = true, WIDE = EPI_WIDE;
    bf16_t* YE; const float* grow;
    __device__ __forceinline__ void operator()(const AccT& acc, const pg8::Unit& u, int wr, int wc, int fr, int fq) const {
        const int row0 = u.pm * 256 + wr * 64 + fr, col0 = (u.pn & 7) * 256 + wc * CW + 8 * fq;
#pragma unroll
        for (int ai = 0; ai < 2; ++ai)
#pragma unroll
            for (int m = 0; m < 4; ++m) { const int r = row0 + ai * 128 + m * 16; const float gt = grow[r]; bf16_t* rowp = YE + (size_t)r * D + col0;
#pragma unroll
                for (int bj = 0; bj < 2; ++bj) { const f32x4 v0 = acc[ai][bj][m][0] * gt, v1 = acc[ai][bj][m][1] * gt;
                    u32x4 w; w.x = pk2c(v0[0], v0[1]); w.y = pk2c(v0[2], v0[3]); w.z = pk2c(v1[0], v1[1]); w.w = pk2c(v1[2], v1[3]);
                    *(u32x4*)(rowp + bj * CBJ) = w; } }
    }
};
struct EpiMla {
    static constexpr bool PERM = true, WIDE = EPI_WIDE;
    bf16_t* Q; bf16_t* KF; bf16_t* VF; const float* rinv; const f32x2* rope;
    __device__ __forceinline__ void operator()(const AccT& acc, const pg8::Unit& u, int wr, int wc, int fr, int fq) const {
        const int row0 = u.pm * 256 + wr * 64 + fr;
        if (u.z == 0) {
#pragma unroll
            for (int ai = 0; ai < 2; ++ai)
#pragma unroll
                for (int m = 0; m < 4; ++m) { const int r = row0 + ai * 128 + m * 16, b = r >> 12, t = r & 4095; const float ri = rinv[r];
#pragma unroll
                    for (int bj = 0; bj < 2; ++bj) { const int c8 = u.pn * 256 + bj * CBJ + wc * CW + 8 * fq, h = c8 / 192, dd = c8 % 192;
                        f32x4 v0 = acc[ai][bj][m][0] * ri, v1 = acc[ai][bj][m][1] * ri;
                        if (dd >= 128) { const int i0 = (dd - 128) >> 1; const f32x4 cs0 = *(const f32x4*)(rope + t * 32 + i0), cs1 = *(const f32x4*)(rope + t * 32 + i0 + 2);
                            const f32x4 a = v0, c = v1;
                            v0[0] = a[0] * cs0[0] - a[1] * cs0[1]; v0[1] = a[0] * cs0[1] + a[1] * cs0[0]; v0[2] = a[2] * cs0[2] - a[3] * cs0[3]; v0[3] = a[2] * cs0[3] + a[3] * cs0[2];
                            v1[0] = c[0] * cs1[0] - c[1] * cs1[1]; v1[1] = c[0] * cs1[1] + c[1] * cs1[0]; v1[2] = c[2] * cs1[2] - c[3] * cs1[3]; v1[3] = c[2] * cs1[3] + c[3] * cs1[2]; }
                        u32x4 w; w.x = pk2c(v0[0], v0[1]); w.y = pk2c(v0[2], v0[3]); w.z = pk2c(v1[0], v1[1]); w.w = pk2c(v1[2], v1[3]);
                        *(u32x4*)(Q + ((size_t)((b * 8 + h) * TL + t)) * 192 + dd) = w; } }
        } else {
            const int h = u.pn;
#pragma unroll
            for (int ai = 0; ai < 2; ++ai)
#pragma unroll
                for (int m = 0; m < 4; ++m) { const int r = row0 + ai * 128 + m * 16; const float ri = rinv[R + r];
                    int b, pos; if (r < RL) { b = r >> 12; pos = TC + (r & 4095); } else { b = (r - RL) >> 8; pos = (r - RL) & 255; }
                    const size_t kv = (size_t)((b * 8 + h) * KSEQ + pos);
#pragma unroll
                    for (int bj = 0; bj < 2; ++bj) { const f32x4 v0 = acc[ai][bj][m][0] * ri, v1 = acc[ai][bj][m][1] * ri;
                        u32x4 w; w.x = pk2c(v0[0], v0[1]); w.y = pk2c(v0[2], v0[3]); w.z = pk2c(v1[0], v1[1]); w.w = pk2c(v1[2], v1[3]);
                        const int ct = wc * CW + bj * CBJ + 8 * fq;
                        if (ct < 128) *(u32x4*)(KF + kv * 192 + ct) = w; else *(u32x4*)(VF + kv * 128 + ct - 128) = w; } }
        }
    }
};
__device__ __forceinline__ void phase_router(const Frame& F, int l, int nrows) {
    LAS f32x4* WR = (LAS f32x4*)F.lds;
    LAS float* NWS = (LAS float*)(F.lds + LDS_XTRA); LAS float* SHL = NWS + 2048;
    const float* wr = F.in[I_ROUT] + (size_t)l * D * NE;
    for (int i = F.tid; i < 2048 * 4; i += NTHR) { const int d = i >> 2, e4 = i & 3; const int j = d >> 9, lane_ = (d >> 3) & 63, q = d & 7;
        WR[e4 * 2048 + (j * 8 + q) * 64 + lane_] = *(const f32x4*)(wr + (size_t)d * NE + e4 * 4); }
    const float* nf = F.in[I_NFFN] + (size_t)l * D; const bf16_t* XA = F.w<const bf16_t>(WS_XA); const bf16_t* DL = F.w<const bf16_t>(WS_DELTA);
    auto load_base = [&](int r, float (&o)[32]) { if (l == 0) load_row_f32(x_in_row(F, r), F.lane, o); else load_row_bf16(XA + (size_t)r * D, F.lane, o); };
    u32x4 dn[4];
#define LOAD_DELTA(r_, d_) do { _Pragma("unroll") for (int j_ = 0; j_ < 4; ++j_) (d_)[j_] = *(const u32x4*)(DL + (size_t)(r_) * D + (j_ * 64 + F.lane) * 8); } while (0)
    const int per = (nrows + F.G - 1) / F.G, r0 = F.bid * per, r1 = (r0 + per < nrows) ? r0 + per : nrows;
    int cur = -1; float vn[32];
    { const int r = r0 + F.wave; if (r < r1) { load_base(r, vn); LOAD_DELTA(r, dn); } }
    const int hi5 = (F.lane >> 5) & 1, hi4 = (F.lane >> 4) & 1, hi3 = (F.lane >> 3) & 1, hi2 = (F.lane >> 2) & 1, myexp = 8 * hi5 + 4 * hi4 + 2 * hi3 + hi2;
    for (int rb = r0; rb < r1; rb += NWAVES) {
        const int r = rb + F.wave;
        const int bs_first = row_bsel(rb), bs_last = row_bsel((rb + NWAVES - 1 < r1 ? rb + NWAVES - 1 : r1 - 1));
        float v[32];
#pragma unroll
        for (int j = 0; j < 4; ++j) { float o8[8]; unpack8(dn[j], o8);
#pragma unroll
            for (int q = 0; q < 8; ++q) v[8 * j + q] = vn[8 * j + q] + o8[q]; }
        if (r < r1) store_row_bf16(F.w<bf16_t>(WS_X1B) + (size_t)r * D, F.lane, v);
        { const int rn = r + NWAVES; if (rn < r1) { load_base(rn, vn); LOAD_DELTA(rn, dn); } }
        for (int pass = 0; pass < (bs_first == bs_last ? 1 : 2); ++pass) {
            const int bs = pass == 0 ? bs_first : bs_last;
            if (bs != cur) {
                __syncthreads();
                for (int i = F.tid; i < 2048; i += NTHR) { NWS[i] = nf[i] * (1.0f + mod_ptr(F, l, bs, 4)[i]); SHL[i] = mod_ptr(F, l, bs, 3)[i]; }
                __syncthreads();
                cur = bs;
            }
            if (r < r1 && row_bsel(r) == bs) {
                float ss = 0.f;
#pragma unroll
                for (int i = 0; i < 32; ++i) ss += v[i] * v[i];
                const float rinv = rsqrtf(wave_sum(ss) * (1.0f / D) + EPS);
                float lg[16];
#pragma unroll
                for (int e = 0; e < 16; ++e) lg[e] = 0.f;
#pragma unroll
                for (int j = 0; j < 4; ++j) { const f32x4 na = *(const LAS f32x4*)(NWS + (j * 64 + F.lane) * 8), nb = *(const LAS f32x4*)(NWS + (j * 64 + F.lane) * 8 + 4);
                    const f32x4 ha = *(const LAS f32x4*)(SHL + (j * 64 + F.lane) * 8), hb = *(const LAS f32x4*)(SHL + (j * 64 + F.lane) * 8 + 4);
#pragma unroll
                    for (int q = 0; q < 8; ++q) { const float h = v[8 * j + q] * rinv * (q < 4 ? na[q & 3] : nb[q & 3]) + (q < 4 ? ha[q & 3] : hb[q & 3]); v[8 * j + q] = h;
#pragma unroll
                        for (int e4 = 0; e4 < 4; ++e4) { const f32x4 w = WR[e4 * 2048 + (j * 8 + q) * 64 + F.lane]; lg[4 * e4 + 0] += h * w[0]; lg[4 * e4 + 1] += h * w[1]; lg[4 * e4 + 2] += h * w[2]; lg[4 * e4 + 3] += h * w[3]; } } }
                store_row_bf16(F.w<bf16_t>(WS_H) + (size_t)r * D, F.lane, v);
                float r8[8], r4[4], r2[2], r1v;
#pragma unroll
                for (int i = 0; i < 8; ++i) { const float mine = hi5 ? lg[8 + i] : lg[i], oth = hi5 ? lg[i] : lg[8 + i]; r8[i] = mine + __shfl_xor(oth, 32); }
#pragma unroll
                for (int i = 0; i < 4; ++i) { const float mine = hi4 ? r8[4 + i] : r8[i], oth = hi4 ? r8[i] : r8[4 + i]; r4[i] = mine + __shfl_xor(oth, 16); }
#pragma unroll
                for (int i = 0; i < 2; ++i) { const float mine = hi3 ? r4[2 + i] : r4[i], oth = hi3 ? r4[i] : r4[2 + i]; r2[i] = mine + __shfl_xor(oth, 8); }
                { const float mine = hi2 ? r2[1] : r2[0], oth = hi2 ? r2[0] : r2[1]; r1v = mine + __shfl_xor(oth, 4); }
                r1v += __shfl_xor(r1v, 2); r1v += __shfl_xor(r1v, 1);
                float mx = r1v;
                mx = fmaxf(mx, __shfl_xor(mx, 4)); mx = fmaxf(mx, __shfl_xor(mx, 8)); mx = fmaxf(mx, __shfl_xor(mx, 16)); mx = fmaxf(mx, __shfl_xor(mx, 32));
                const float ex = expf(r1v - mx); float sm = ex;
                sm += __shfl_xor(sm, 4); sm += __shfl_xor(sm, 8); sm += __shfl_xor(sm, 16); sm += __shfl_xor(sm, 32);
                const float aff = ex / sm;
                if ((F.lane & 3) == 0) { if (r < RL) F.w<float>(WS_AFFL)[((size_t)((r >> 12) * NE + myexp)) * TL + (r & 4095)] = aff;
                                         else { const int rc = r - RL; F.w<float>(WS_AFFC)[((size_t)((rc >> 8) * NE + myexp)) * TC + (rc & 255)] = aff; } }
            }
        }
    }
}

__device__ __forceinline__ void phase_topk(const Frame& F, int nunits, int mrows) {
    LAS unsigned* hist = (LAS unsigned*)F.lds;
    LAS unsigned* ctl = hist + 256;
    LAS unsigned* wtot = ctl + 8;
    for (int u = F.bid; u < nunits; u += F.G) {
        const bool isc = u >= 64; const int be = isc ? u - 64 : u, T = isc ? TC : TL, cap = isc ? CAPC : CAPL;
        const float* src = (isc ? F.w<const float>(WS_AFFC) : F.w<const float>(WS_AFFL)) + (size_t)be * T;
        unsigned key[8];
        if (F.tid * 8 < T) { const u32x4 a = *(const u32x4*)(src + F.tid * 8), b = *(const u32x4*)(src + F.tid * 8 + 4); key[0] = a.x; key[1] = a.y; key[2] = a.z; key[3] = a.w; key[4] = b.x; key[5] = b.y; key[6] = b.z; key[7] = b.w; }
        else {
#pragma unroll
            for (int i = 0; i < 8; ++i) key[i] = 0u; }
        unsigned prefix = 0u, mask = 0u, k = (unsigned)cap;
#pragma unroll 1
        for (int shift = 24; shift >= 0; shift -= 8) {
            __syncthreads();
            if (F.tid < 256) hist[F.tid] = 0u;
            __syncthreads();
#pragma unroll
            for (int i = 0; i < 8; ++i) if ((key[i] & mask) == prefix && key[i] != 0u) __hip_atomic_fetch_add(&hist[(key[i] >> shift) & 255u], 1u, __ATOMIC_RELAXED, __HIP_MEMORY_SCOPE_WORKGROUP);
            __syncthreads();
            if (F.wave == 0) {
                const unsigned c0 = hist[4 * F.lane], c1 = hist[4 * F.lane + 1], c2 = hist[4 * F.lane + 2], c3 = hist[4 * F.lane + 3];
                const unsigned s = c0 + c1 + c2 + c3;
                unsigned incl = s;
#pragma unroll
                for (int o = 1; o < 64; o <<= 1) { const unsigned t = __shfl_down(incl, o); if (F.lane + o < 64) incl += t; }
                const unsigned suf = incl - s;
                if (suf < k && k <= suf + s) {
                    unsigned cum = suf; int bin; unsigned nk;
                    if (cum + c3 >= k) { bin = 3; nk = k - cum; } else { cum += c3;
                    if (cum + c2 >= k) { bin = 2; nk = k - cum; } else { cum += c2;
                    if (cum + c1 >= k) { bin = 1; nk = k - cum; } else { cum += c1; bin = 0; nk = k - cum; } } }
                    ctl[0] = (unsigned)(4 * F.lane + bin); ctl[1] = nk;
                }
            }
            __syncthreads();
            prefix |= ctl[0] << shift; mask |= 255u << shift; k = ctl[1];
        }
        const unsigned thr = prefix, keq = k;
        unsigned cg = 0, ce = 0;
#pragma unroll
        for (int i = 0; i < 8; ++i) { cg += key[i] > thr; ce += key[i] == thr; }
        unsigned pk = cg | (ce << 16), inc = pk;
#pragma unroll
        for (int o = 1; o < 64; o <<= 1) { const unsigned t = __shfl_up(inc, o); if (F.lane >= o) inc += t; }
        __syncthreads();
        if (F.lane == 63) wtot[F.wave] = inc;
        __syncthreads();
        unsigned base = 0, total = 0;
#pragma unroll
        for (int w = 0; w < NWAVES; ++w) { const unsigned t = wtot[w]; if (w < F.wave) base += t; total += t; }
        const unsigned excl = base + inc - pk;
        unsigned grun = excl & 0xffffu, erun = excl >> 16; const unsigned ngt = total & 0xffffu;
        const int b = be >> 4, e = be & 15;
        const int mbase = e * mrows + (isc ? 2048 + b * CAPC : b * CAPL), rbase = isc ? RL + b * TC : b * TL;
        int* idx = F.w<int>(WS_ROWMAP) + mbase; float* gat = F.w<float>(WS_GROW) + mbase;
        int* pos = F.w<int>(WS_POS) + (size_t)rbase * NE + e;
        if (isc && b == 0 && F.tid < 128) { F.w<int>(WS_ROWMAP)[e * mrows + 2176 + F.tid] = R; F.w<float>(WS_GROW)[e * mrows + 2176 + F.tid] = 0.f; }
        if (F.tid * 8 < T) {
#pragma unroll
            for (int i = 0; i < 8; ++i) { const int t = F.tid * 8 + i; int slot = -1;
                if (key[i] > thr) slot = (int)grun++;
                else if (key[i] == thr) { if (erun < keq) slot = (int)(ngt + erun); ++erun; }
                if (slot >= 0) { idx[slot] = rbase + t; gat[slot] = __uint_as_float(key[i]); }
                pos[(size_t)t * NE] = slot; }
        }
    }
}

__device__ __forceinline__ void phase_combine(const Frame& F, int l, int nrows, int mrows, bool last) {
    const float* nw = last ? F.in[I_FN] : F.in[I_NMIX] + (size_t)(l + 1) * D;
    LAS float* G2 = (LAS float*)F.lds; LAS float* NWS = G2 + 2048; LAS float* SHL = NWS + 2048;
    const int per = (nrows + F.G - 1) / F.G, r0 = F.bid * per, r1 = (r0 + per < nrows) ? r0 + per : nrows;
    const bf16_t* X1 = F.w<const bf16_t>(WS_X1B); const int* POS = F.w<const int>(WS_POS); const bf16_t* YE = F.w<const bf16_t>(WS_YE);
    int cur = -1;
    float vn[32]; int sn = -1;
    { const int r = r0 + F.wave; if (r < r1) { load_row_bf16(X1 + (size_t)r * D, F.lane, vn); if (F.lane < 16) sn = POS[(size_t)r * NE + F.lane]; } }
    for (int rb = r0; rb < r1; rb += NWAVES) {
        const int r = rb + F.wave;
        const int bs_first = row_bsel(rb), bs_last = row_bsel((rb + NWAVES - 1 < r1 ? rb + NWAVES - 1 : r1 - 1));
        float v[32]; int spos = sn;
#pragma unroll
        for (int i = 0; i < 32; ++i) v[i] = vn[i];
        { const int rn = r + NWAVES; sn = -1; if (rn < r1) { load_row_bf16(X1 + (size_t)rn * D, F.lane, vn); if (F.lane < 16) sn = POS[(size_t)rn * NE + F.lane]; } }
        for (int pass = 0; pass < (bs_first == bs_last ? 1 : 2); ++pass) {
            const int bs = pass == 0 ? bs_first : bs_last;
            if (bs != cur) {
                __syncthreads();
                for (int i = F.tid; i < 2048; i += NTHR) { G2[i] = mod_ptr(F, l, bs, 5)[i];
                    if (last) { NWS[i] = nw[i]; SHL[i] = 0.f; } else { NWS[i] = nw[i] * (1.0f + mod_ptr(F, l + 1, bs, 1)[i]); SHL[i] = mod_ptr(F, l + 1, bs, 0)[i]; } }
                __syncthreads();
                cur = bs;
            }
            if (r < r1 && row_bsel(r) == bs) {
                float a[32];
#pragma unroll
                for (int i = 0; i < 32; ++i) a[i] = 0.f;
                const int mbase = r < RL ? (r >> 12) * CAPL : 2048 + ((r - RL) >> 8) * CAPC;
                unsigned long long m = __ballot(F.lane < 16 && spos >= 0);
#pragma unroll 1
                while (m) {
                    const int e0 = __builtin_ctzll(m); m &= m - 1; const bool two = (m != 0ull); const int e1 = two ? __builtin_ctzll(m) : e0; if (two) m &= m - 1;
                    const int s0 = __shfl(spos, e0), s1 = __shfl(spos, e1);
                    const u32x4* y0 = (const u32x4*)(YE + ((size_t)e0 * mrows + mbase + s0) * D); const u32x4* y1 = (const u32x4*)(YE + ((size_t)e1 * mrows + mbase + s1) * D);
                    u32x4 w0[4], w1[4];
#pragma unroll
                    for (int j = 0; j < 4; ++j) { w0[j] = y0[j * 64 + F.lane]; w1[j] = y1[j * 64 + F.lane]; }
#pragma unroll
                    for (int j = 0; j < 4; ++j) { float o[8]; unpack8(w0[j], o);
#pragma unroll
                        for (int q = 0; q < 8; ++q) a[8 * j + q] += o[q];
                        if (two) { unpack8(w1[j], o);
#pragma unroll
                            for (int q = 0; q < 8; ++q) a[8 * j + q] += o[q]; } }
                }
#pragma unroll
                for (int j = 0; j < 4; ++j) { const f32x4 ga = *(const LAS f32x4*)(G2 + (j * 64 + F.lane) * 8), gb = *(const LAS f32x4*)(G2 + (j * 64 + F.lane) * 8 + 4);
#pragma unroll
                    for (int q = 0; q < 4; ++q) { v[8 * j + q] += ga[q] * a[8 * j + q]; v[8 * j + 4 + q] += gb[q] * a[8 * j + 4 + q]; } }
                if (!last) store_row_bf16(F.w<bf16_t>(WS_XA) + (size_t)r * D, F.lane, v);
                float ss = 0.f;
#pragma unroll
                for (int i = 0; i < 32; ++i) ss += v[i] * v[i];
                const float rinv = rsqrtf(wave_sum(ss) * (1.0f / D) + EPS);
#pragma unroll
                for (int j = 0; j < 4; ++j) { const f32x4 na = *(const LAS f32x4*)(NWS + (j * 64 + F.lane) * 8), nb = *(const LAS f32x4*)(NWS + (j * 64 + F.lane) * 8 + 4);
                    const f32x4 ha = *(const LAS f32x4*)(SHL + (j * 64 + F.lane) * 8), hb = *(const LAS f32x4*)(SHL + (j * 64 + F.lane) * 8 + 4);
#pragma unroll
                    for (int q = 0; q < 4; ++q) { v[8 * j + q] = v[8 * j + q] * rinv * na[q] + ha[q]; v[8 * j + 4 + q] = v[8 * j + 4 + q] * rinv * nb[q] + hb[q]; } }
                if (last) store_row_f32(F.out + (size_t)r * D, F.lane, v); else store_row_bf16(F.w<bf16_t>(WS_H) + (size_t)r * D, F.lane, v);
            }
        }
    }
}
__device__ __forceinline__ int step_row(int s, int b, int d) {
    if (s < TC) { const int tc = d ? (TC - 1 - s) : s; return RL + b * TC + tc; }
    const int tl = s - TC, t = d ? (TL - 1 - tl) : tl; return b * TL + t;
}
constexpr int U0_Q = 0, U0_G = 1024, U0_LG = 2048, U0_FF = 3072, U0_FB = 4096, U0_I = 5120, U0_LX = 6144;

__device__ __forceinline__ void phase_lru_gates(const Frame& F) {
    LAS bf16_t* LXS = (LAS bf16_t*)F.lds;
    LAS bf16_t* XCB = LXS + 68 * 128;
    LAS bf16_t* OUT = XCB + 64 * 136;
    const bf16_t* U0 = F.w<const bf16_t>(WS_U0);
    const int hb = F.bid & 7, w = F.wave, l15 = F.lane & 15, l4 = F.lane >> 4;
    const int nper = F.G >> 3;
    if ((F.G & 7) != 0 || nper == 0) return;
    bf16x8 bw[4][4];
    { const bf16_t* WL = F.w<const bf16_t>(WS_WL);
#pragma unroll
      for (int mat = 0; mat < 4; ++mat)
#pragma unroll
          for (int ks = 0; ks < 4; ++ks) bw[mat][ks] = *(const bf16x8*)(WL + ((size_t)(mat * 8 + hb) * 128 + 16 * w + l15) * 128 + ks * 32 + 8 * l4); }
    const int ch = hb * 128 + 16 * w + l15;
    float cba[2], cbx[2], csp[2];
#pragma unroll
    for (int d = 0; d < 2; ++d) { cba[d] = F.in[I_LBA][d * 1024 + ch]; cbx[d] = F.in[I_LBX][d * 1024 + ch]; csp[d] = -8.0f * softplusf_(-F.in[I_LLAM][d * 1024 + ch]); }
    const int cc = F.tid & 127, chc = hb * 128 + cc; const float* cw = F.in[I_LCW];
    const float w0 = cw[chc], w1 = cw[1024 + chc], w2 = cw[2048 + chc], w3 = cw[3072 + chc], cb = F.in[I_LCB][chc];
    for (int rb = F.bid >> 3; rb < R / 64; rb += nper) {
        int rowbase, t0, T;
        if (rb < RL / 64) { const int b = rb >> 6; t0 = (rb & 63) * 64; T = TL; rowbase = b * TL; } else { const int rc = rb - RL / 64, b = rc >> 2; t0 = (rc & 3) * 64; T = TC; rowbase = RL + b * TC; }
        __syncthreads();
        for (int c = F.tid; c < 67 * 16; c += NTHR) { const int rr = c >> 4, c8 = (c & 15) * 8, t = t0 - 2 + rr;
            u32x4 v = (u32x4){0u, 0u, 0u, 0u}; if (t >= 0 && t < T) v = *(const u32x4*)(U0 + (size_t)(rowbase + t) * EVN + U0_LX + hb * 128 + c8);
            *(LAS u32x4*)(LXS + rr * 128 + c8) = v; }
        __syncthreads();
        { const int tq = F.tid >> 7; float x0 = bf2f(LXS[(16 * tq) * 128 + cc]), x1 = bf2f(LXS[(16 * tq + 1) * 128 + cc]), x2 = bf2f(LXS[(16 * tq + 2) * 128 + cc]);
#pragma unroll
          for (int i = 0; i < 16; ++i) { const int tt = 16 * tq + i; const float x3 = bf2f(LXS[(tt + 3) * 128 + cc]);
              XCB[tt * 136 + cc] = f2bf(w0 * x0 + w1 * x1 + w2 * x2 + w3 * x3 + cb); x0 = x1; x1 = x2; x2 = x3; } }
        __syncthreads();
#pragma unroll 1
        for (int mt = 0; mt < 4; ++mt) {
            bf16x8 af[4];
#pragma unroll
            for (int ks = 0; ks < 4; ++ks) af[ks] = *(const LAS bf16x8*)(XCB + (mt * 16 + l15) * 136 + ks * 32 + 8 * l4);
            f32x4 acc[4];
#pragma unroll
            for (int mat = 0; mat < 4; ++mat) { acc[mat] = (f32x4){0.f, 0.f, 0.f, 0.f};
#pragma unroll
                for (int ks = 0; ks < 4; ++ks) acc[mat] = __builtin_amdgcn_mfma_f32_16x16x32_bf16(af[ks], bw[mat][ks], acc[mat], 0, 0, 0); }
#pragma unroll
            for (int j = 0; j < 4; ++j) { const int tt = mt * 16 + l4 * 4 + j; const float xc = bf2f(XCB[tt * 136 + 16 * w + l15]);
#pragma unroll
                for (int d = 0; d < 2; ++d) { const float r = sigmoidf_(acc[d * 2 + 0][j] + cba[d]), ig = sigmoidf_(acc[d * 2 + 1][j] + cbx[d]);
                    const float la = r * csp[d], bb = __builtin_amdgcn_sqrtf(1.0f - __expf(2.0f * la)) * ig * xc;
                    OUT[((d * 2 + 0) * 64 + tt) * 128 + 16 * w + l15] = f2bf(la); OUT[((d * 2 + 1) * 64 + tt) * 128 + 16 * w + l15] = f2bf(bb); } }
        }
        __syncthreads();
#pragma unroll
        for (int q = 0; q < 8; ++q) { const int p = F.tid + NTHR * q, arr = p >> 10, tt = (p >> 4) & 63, c8 = (p & 15) * 8, d = arr >> 1;
            bf16_t* dst = (arr & 1) ? F.w<bf16_t>(WS_BB) : F.w<bf16_t>(WS_LA);
            *(u32x4*)(dst + ((size_t)d * R + rowbase + t0 + tt) * 1024 + hb * 128 + c8) = *(const LAS u32x4*)(OUT + (arr * 64 + tt) * 128 + c8); }
    }
}

__device__ __forceinline__ void lru_scan_unit(const Frame& F, int u) {
    const int b = u >> 5, cg = (u >> 1) & 15, d = u & 1, cl = F.lane & 15, sg = F.lane >> 4, seg = F.wave * 4 + sg, ch = cg * 64 + 4 * cl;
    LAS float* HE = (LAS float*)F.lds; LAS float* AT = HE + 32 * 64;
    const bf16_t* LA = F.w<const bf16_t>(WS_LA) + (size_t)d * R * 1024 + ch; const bf16_t* BB = F.w<const bf16_t>(WS_BB) + (size_t)d * R * 1024 + ch;
    bf16_t* HD = F.w<bf16_t>(WS_HD) + (size_t)d * R * 1024 + ch;
    const int s0 = seg * 136;
    float h[4] = {0.f, 0.f, 0.f, 0.f}, A[4] = {0.f, 0.f, 0.f, 0.f};
#pragma unroll 1
    for (int sb = 0; sb < 136; sb += 17) { u32x2 la[17], bb[17];
#pragma unroll
        for (int i = 0; i < 17; ++i) { const size_t o = (size_t)step_row(s0 + sb + i, b, d) * 1024; la[i] = *(const u32x2*)(LA + o); bb[i] = *(const u32x2*)(BB + o); }
#pragma unroll
        for (int i = 0; i < 17; ++i) { const float l0 = bflo(la[i].x), l1 = bfhi(la[i].x), l2 = bflo(la[i].y), l3 = bfhi(la[i].y);
            h[0] = __expf(l0) * h[0] + bflo(bb[i].x); h[1] = __expf(l1) * h[1] + bfhi(bb[i].x); h[2] = __expf(l2) * h[2] + bflo(bb[i].y); h[3] = __expf(l3) * h[3] + bfhi(bb[i].y);
            A[0] += l0; A[1] += l1; A[2] += l2; A[3] += l3; } }
    __syncthreads();
    *(LAS f32x4*)(HE + seg * 64 + 4 * cl) = (f32x4){h[0], h[1], h[2], h[3]}; *(LAS f32x4*)(AT + seg * 64 + 4 * cl) = (f32x4){A[0], A[1], A[2], A[3]};
    __syncthreads();
    h[0] = h[1] = h[2] = h[3] = 0.f;
    for (int s2 = 0; s2 < seg; ++s2) { const f32x4 a4 = *(const LAS f32x4*)(AT + s2 * 64 + 4 * cl), h4 = *(const LAS f32x4*)(HE + s2 * 64 + 4 * cl);
#pragma unroll
        for (int q = 0; q < 4; ++q) h[q] = __expf(a4[q]) * h[q] + h4[q]; }
#pragma unroll 1
    for (int sb = 0; sb < 136; sb += 17) { u32x2 la[17], bb[17];
#pragma unroll
        for (int i = 0; i < 17; ++i) { const size_t o = (size_t)step_row(s0 + sb + i, b, d) * 1024; la[i] = *(const u32x2*)(LA + o); bb[i] = *(const u32x2*)(BB + o); }
#pragma unroll
        for (int i = 0; i < 17; ++i) { const size_t o = (size_t)step_row(s0 + sb + i, b, d) * 1024;
            h[0] = __expf(bflo(la[i].x)) * h[0] + bflo(bb[i].x); h[1] = __expf(bfhi(la[i].x)) * h[1] + bfhi(bb[i].x); h[2] = __expf(bflo(la[i].y)) * h[2] + bflo(bb[i].y); h[3] = __expf(bfhi(la[i].y)) * h[3] + bfhi(bb[i].y);
            u32x2 o2; o2.x = pk2c(h[0], h[1]); o2.y = pk2c(h[2], h[3]); *(u32x2*)(HD + o) = o2; } }
}

__device__ __forceinline__ void hgrn_scan_unit(const Frame& F, int u) {
    const int b = u >> 5, h = (u >> 2) & 7, d = (u >> 1) & 1, eh = u & 1;
    LAS float* FS = (LAS float*)F.lds;
    LAS float* QS = FS + 32 * 128;
    LAS float* VS = QS + 32 * 128;
    LAS float* OP = VS + 32 * 64;
    const bf16_t* U0 = F.w<const bf16_t>(WS_U0);
    bf16_t* OD = F.w<bf16_t>(WS_OD) + (size_t)d * R * 1024 + h * 128 + eh * 64;
    const int fcol = (d ? U0_FB : U0_FF) + h * 128, qcol = U0_Q + h * 128, vcol = U0_I + h * 128 + eh * 64;
    const int si = F.tid >> 4, c8 = (F.tid & 15) * 8;
    const int vi = F.tid >> 3, v8 = (F.tid & 7) * 8;
    float lbv[8];
#pragma unroll
    for (int q = 0; q < 8; ++q) lbv[q] = F.w<const float>(WS_LB)[d * 1024 + h * 128 + c8 + q];
    float S[16];
#pragma unroll
    for (int i = 0; i < 16; ++i) S[i] = 0.f;
    u32x4 rf, rq, rv = (u32x4){0u, 0u, 0u, 0u};
    { const size_t ro = (size_t)step_row(si, b, d) * EVN; rf = *(const u32x4*)(U0 + ro + fcol + c8); rq = *(const u32x4*)(U0 + ro + qcol + c8);
      if (F.tid < 256) rv = *(const u32x4*)(U0 + (size_t)step_row(vi, b, d) * EVN + vcol + v8); }
#pragma unroll 1
    for (int blk = 0; blk < KSEQ / 32; ++blk) {
        { float fo[8], qo[8]; unpack8(rf, fo); unpack8(rq, qo);
#pragma unroll
          for (int q = 0; q < 8; ++q) { FS[si * 128 + c8 + q] = lbv[q] + (1.0f - lbv[q]) * sigmoidf_(fo[q]); QS[si * 128 + c8 + q] = siluf_(qo[q]); }
          if (F.tid < 256) { float vo[8]; unpack8(rv, vo);
#pragma unroll
              for (int q = 0; q < 8; ++q) VS[vi * 64 + v8 + q] = vo[q]; } }
        __syncthreads();
        if (blk + 1 < KSEQ / 32) { const int s = (blk + 1) * 32; const size_t ro = (size_t)step_row(s + si, b, d) * EVN; rf = *(const u32x4*)(U0 + ro + fcol + c8); rq = *(const u32x4*)(U0 + ro + qcol + c8);
            if (F.tid < 256) rv = *(const u32x4*)(U0 + (size_t)step_row(s + vi, b, d) * EVN + vcol + v8); }
#pragma unroll 2
        for (int i = 0; i < 32; ++i) {
            const LAS f32x4* fp = (const LAS f32x4*)(FS + i * 128 + F.wave * 16); const LAS f32x4* qp = (const LAS f32x4*)(QS + i * 128 + F.wave * 16);
            const float v = VS[i * 64 + F.lane]; float o = 0.f;
#pragma unroll
            for (int g = 0; g < 4; ++g) { const f32x4 f4 = fp[g], q4 = qp[g];
#pragma unroll
                for (int q = 0; q < 4; ++q) { float s_ = S[4 * g + q]; s_ = f4[q] * (s_ - v) + v; S[4 * g + q] = s_; o += q4[q] * s_; } }
            OP[(i * 8 + F.wave) * 64 + F.lane] = o;
        }
        __syncthreads();
        { const int i = F.tid >> 4, e4 = (F.tid & 15) * 4; f32x4 a = (f32x4){0.f, 0.f, 0.f, 0.f};
#pragma unroll
          for (int w = 0; w < 8; ++w) a += *(const LAS f32x4*)(OP + (i * 8 + w) * 64 + e4);
          u32x2 o2; o2.x = pk2(a[0], a[1]); o2.y = pk2(a[2], a[3]);
          *(u32x2*)(OD + (size_t)step_row(blk * 32 + i, b, d) * 1024 + e4) = o2; }
    }
}

struct Mix0Raw { u32x4 of[2], ob[2], g[2], hf[2], hb[2], lg[2]; };
__device__ __forceinline__ void mix0_load(const Frame& F, int r, int c0, Mix0Raw& x) {
    const bf16_t* U0 = F.w<const bf16_t>(WS_U0); const bf16_t* OD = F.w<const bf16_t>(WS_OD); const bf16_t* HD = F.w<const bf16_t>(WS_HD);
#pragma unroll
    for (int hh = 0; hh < 2; ++hh) {
        x.of[hh] = *(const u32x4*)(OD + (size_t)r * 1024 + c0 + 8 * hh); x.ob[hh] = *(const u32x4*)(OD + ((size_t)R + r) * 1024 + c0 + 8 * hh);
        x.g[hh] = *(const u32x4*)(U0 + (size_t)r * EVN + U0_G + c0 + 8 * hh);
        x.hf[hh] = *(const u32x4*)(HD + (size_t)r * 1024 + c0 + 8 * hh); x.hb[hh] = *(const u32x4*)(HD + ((size_t)R + r) * 1024 + c0 + 8 * hh);
        x.lg[hh] = *(const u32x4*)(U0 + (size_t)r * EVN + U0_LG + c0 + 8 * hh); }
}
__device__ __forceinline__ void phase_mix0_finish(const Frame& F) {
    const int c0 = F.lane * 16;
    float gain[16];
#pragma unroll
    for (int q = 0; q < 16; ++q) gain[q] = F.in[I_HGON][c0 + q];
    Mix0Raw nx;
    if (F.gw() < R) mix0_load(F, F.gw(), c0, nx);
    for (int r = F.gw(); r < R; r += F.ngw()) {
        const Mix0Raw x = nx;
        if (r + F.ngw() < R) mix0_load(F, r + F.ngw(), c0, nx);
        float o[16], t8[8], u8[8];
#pragma unroll
        for (int hh = 0; hh < 2; ++hh) { unpack8(x.of[hh], t8); unpack8(x.ob[hh], u8);
#pragma unroll
            for (int q = 0; q < 8; ++q) o[8 * hh + q] = t8[q] + u8[q]; }
        float ss = 0.f;
#pragma unroll
        for (int q = 0; q < 16; ++q) ss += o[q] * o[q];
        ss += __shfl_xor(ss, 1); ss += __shfl_xor(ss, 2); ss += __shfl_xor(ss, 4);
        const float rinv = rsqrtf(ss * (1.0f / 128.0f) + EPS);
        bf16_t* yr = F.w<bf16_t>(WS_Y) + (size_t)r * D;
#pragma unroll
        for (int hh = 0; hh < 2; ++hh) { unpack8(x.g[hh], t8); float y[8];
#pragma unroll
            for (int q = 0; q < 8; ++q) y[q] = o[8 * hh + q] * rinv * gain[8 * hh + q] * siluf_(t8[q]);
            u32x4 w; w.x = pk2c(y[0], y[1]); w.y = pk2c(y[2], y[3]); w.z = pk2c(y[4], y[5]); w.w = pk2c(y[6], y[7]); *(u32x4*)(yr + c0 + 8 * hh) = w; }
#pragma unroll
        for (int hh = 0; hh < 2; ++hh) { float a8[8], b8[8], g8[8]; unpack8(x.hf[hh], a8); unpack8(x.hb[hh], b8); unpack8(x.lg[hh], g8);
#pragma unroll
            for (int q = 0; q < 8; ++q) a8[q] = (a8[q] + b8[q]) * gelu_tanh_(g8[q]);
            u32x4 w; w.x = pk2c(a8[0], a8[1]); w.y = pk2c(a8[2], a8[3]); w.z = pk2c(a8[4], a8[5]); w.w = pk2c(a8[6], a8[7]); *(u32x4*)(yr + 1024 + c0 + 8 * hh) = w; }
    }
}
__device__ __forceinline__ void hgrn_chunk_unit(const Frame& F, int u) {
    const int b = u >> 5, h = (u >> 2) & 7, d = (u >> 1) & 1, eh = u & 1;
    constexpr int SQ = 136, ST_ = 72;
    LAS bf16_t* QG = (LAS bf16_t*)F.lds;
    LAS bf16_t* KG = QG + 64 * SQ;
    LAS bf16_t* KLT = KG + 64 * SQ;
    LAS bf16_t* VT = KLT + 128 * ST_;
    LAS bf16_t* STT = VT + 64 * ST_;
    LAS bf16_t* ATT = STT + 64 * SQ;
    LAS bf16_t* OS = ATT + 64 * ST_;
    LAS float* DEC = (LAS float*)(OS + 64 * ST_);
    LAS float* CSQ = DEC + 128;
    const bf16_t* U0 = F.w<const bf16_t>(WS_U0);
    bf16_t* OD = F.w<bf16_t>(WS_OD) + (size_t)d * R * 1024 + h * 128 + eh * 64;
    const int fcol = (d ? U0_FB : U0_FF) + h * 128, qcol = U0_Q + h * 128, vcol = U0_I + h * 128 + eh * 64;
    const int w = F.wave, dp = F.lane;
    const int l15 = F.lane & 15, l4 = F.lane >> 4;
    const float lb0 = F.w<const float>(WS_LB)[d * 1024 + h * 128 + 2 * dp], lb1 = F.w<const float>(WS_LB)[d * 1024 + h * 128 + 2 * dp + 1];
    for (int i = F.tid; i < 64 * SQ / 2; i += NTHR) ((LAS unsigned*)STT)[i] = 0u;
    f32x4 sacc[4];
#pragma unroll
    for (int te = 0; te < 4; ++te) sacc[te] = (f32x4){0.f, 0.f, 0.f, 0.f};
    unsigned rfA[8], rqA[8], rfB[8], rqB[8]; unsigned short rvA[8], rvB[8];
    const long sgn = d ? -(long)EVN : (long)EVN;
#define HG_LOAD(n, rf, rq, rv) do { const bf16_t* base = U0 + (size_t)step_row((n) * 64, b, d) * EVN + (long)(8 * w) * sgn; \
        _Pragma("unroll") for (int i = 0; i < 8; ++i) { const bf16_t* rp = base + (long)i * sgn; rf[i] = *(const unsigned*)(rp + fcol + 2 * dp); rq[i] = *(const unsigned*)(rp + qcol + 2 * dp); rv[i] = rp[vcol + F.lane]; } } while (0)
    HG_LOAD(0, rfA, rqA, rvA); HG_LOAD(1, rfB, rqB, rvB);
    if (w >= 4) __builtin_amdgcn_s_setprio(1);
#pragma unroll 1
    for (int n2 = 0; n2 < KSEQ / 64; n2 += 2) {
        { const int n = n2;

        float k0[8], k1[8], g0[8], g1[8]; float run0 = 0.f, run1 = 0.f;
#pragma unroll
        for (int i = 0; i < 8; ++i) { const float la = bflo(rfA[i]), lc = bfhi(rfA[i]);
            run0 += la; run1 += lc; g0[i] = run0; g1[i] = run1; k0[i] = 1.0f - __builtin_amdgcn_exp2f(la); k1[i] = 1.0f - __builtin_amdgcn_exp2f(lc); }
        *(LAS f32x2*)(CSQ + w * 128 + 2 * dp) = (f32x2){run0, run1};
        { u32x4 wv; wv.x = (unsigned)rvA[0] | ((unsigned)rvA[1] << 16); wv.y = (unsigned)rvA[2] | ((unsigned)rvA[3] << 16); wv.z = (unsigned)rvA[4] | ((unsigned)rvA[5] << 16); wv.w = (unsigned)rvA[6] | ((unsigned)rvA[7] << 16);
          *(LAS u32x4*)(VT + F.lane * ST_ + 8 * w) = wv; }
        __syncthreads();
        float off0 = 0.f, off1 = 0.f, gl0 = 0.f, gl1 = 0.f;
#pragma unroll
        for (int q = 0; q < 8; ++q) { const f32x2 c = *(const LAS f32x2*)(CSQ + q * 128 + 2 * dp); off0 += (q < w) ? c[0] : 0.f; off1 += (q < w) ? c[1] : 0.f; gl0 += c[0]; gl1 += c[1]; }
        const float dc0 = __builtin_amdgcn_exp2f(gl0), dc1 = __builtin_amdgcn_exp2f(gl1);
        if (w == 0) *(LAS f32x2*)(DEC + 2 * dp) = (f32x2){dc0, dc1};
        unsigned kl0[4], kl1[4];
#pragma unroll
        for (int i = 0; i < 8; ++i) {
            const float en0 = __builtin_amdgcn_exp2f(fminf(-(off0 + g0[i]), 115.f)), en1 = __builtin_amdgcn_exp2f(fminf(-(off1 + g1[i]), 115.f));
            const float kg0 = k0[i] * en0, kg1 = k1[i] * en1;
            const float qg0 = bflo(rqA[i]) * __builtin_amdgcn_rcpf(en0), qg1 = bfhi(rqA[i]) * __builtin_amdgcn_rcpf(en1);
            *(LAS unsigned*)(QG + (8 * w + i) * SQ + 2 * dp) = pk2c(qg0, qg1); *(LAS unsigned*)(KG + (8 * w + i) * SQ + 2 * dp) = pk2c(kg0, kg1);
            const unsigned a = pk2c(kg0 * dc0, kg1 * dc1);
            if (i & 1) { kl0[i >> 1] |= a << 16; kl1[i >> 1] |= a & 0xffff0000u; } else { kl0[i >> 1] = a & 0xffffu; kl1[i >> 1] = a >> 16; } }
        *(LAS u32x4*)(KLT + (2 * dp) * ST_ + 8 * w) = (u32x4){kl0[0], kl0[1], kl0[2], kl0[3]};
        *(LAS u32x4*)(KLT + (2 * dp + 1) * ST_ + 8 * w) = (u32x4){kl1[0], kl1[1], kl1[2], kl1[3]};
        __syncthreads();
        if (n + 2 < KSEQ / 64) HG_LOAD(n + 2, rfA, rqA, rvA);
#pragma unroll
        for (int tt = 0; tt < 2; ++tt) { const int t = w + 8 * tt, ti = t >> 2, tj = t & 3;
            f32x4 acc = (f32x4){0.f, 0.f, 0.f, 0.f};
            if (tj <= ti) {
#pragma unroll
                for (int ks = 0; ks < 4; ++ks) { const bf16x8 a = *(const LAS bf16x8*)(QG + (16 * ti + l15) * SQ + ks * 32 + 8 * l4), bb = *(const LAS bf16x8*)(KG + (16 * tj + l15) * SQ + ks * 32 + 8 * l4);
                    acc = __builtin_amdgcn_mfma_f32_16x16x32_bf16(a, bb, acc, 0, 0, 0); } }
#pragma unroll
            for (int r = 0; r < 4; ++r) { const int i = 16 * ti + 4 * l4 + r, j = 16 * tj + l15; ATT[i * ST_ + j] = (j <= i) ? (bf16_t)pk2c(acc[r], 0.f) : (bf16_t)0; } }
        __syncthreads();
#pragma unroll
        for (int tt = 0; tt < 2; ++tt) { const int t = w + 8 * tt, ti = t >> 2, te = t & 3;
            f32x4 acc = (f32x4){0.f, 0.f, 0.f, 0.f};
#pragma unroll
            for (int ks = 0; ks < 4; ++ks) { const bf16x8 a = *(const LAS bf16x8*)(QG + (16 * ti + l15) * SQ + ks * 32 + 8 * l4), bb = *(const LAS bf16x8*)(STT + (16 * te + l15) * SQ + ks * 32 + 8 * l4);
                acc = __builtin_amdgcn_mfma_f32_16x16x32_bf16(a, bb, acc, 0, 0, 0); }
#pragma unroll
            for (int ks = 0; ks < 2; ++ks) { const bf16x8 a = *(const LAS bf16x8*)(ATT + (16 * ti + l15) * ST_ + ks * 32 + 8 * l4), bb = *(const LAS bf16x8*)(VT + (16 * te + l15) * ST_ + ks * 32 + 8 * l4);
                acc = __builtin_amdgcn_mfma_f32_16x16x32_bf16(a, bb, acc, 0, 0, 0); }
#pragma unroll
            for (int r = 0; r < 4; ++r) OS[(16 * ti + 4 * l4 + r) * ST_ + 16 * te + l15] = (bf16_t)pk2c(acc[r], 0.f); }
        { float dc[4];
#pragma unroll
          for (int r = 0; r < 4; ++r) dc[r] = DEC[16 * w + 4 * l4 + r];
          bf16x8 a0 = *(const LAS bf16x8*)(KLT + (16 * w + l15) * ST_ + 8 * l4), a1 = *(const LAS bf16x8*)(KLT + (16 * w + l15) * ST_ + 32 + 8 * l4);
#pragma unroll
          for (int te = 0; te < 4; ++te) {
#pragma unroll
              for (int r = 0; r < 4; ++r) sacc[te][r] *= dc[r];
              const bf16x8 b0 = *(const LAS bf16x8*)(VT + (16 * te + l15) * ST_ + 8 * l4), b1 = *(const LAS bf16x8*)(VT + (16 * te + l15) * ST_ + 32 + 8 * l4);
              sacc[te] = __builtin_amdgcn_mfma_f32_16x16x32_bf16(a0, b0, sacc[te], 0, 0, 0);
              sacc[te] = __builtin_amdgcn_mfma_f32_16x16x32_bf16(a1, b1, sacc[te], 0, 0, 0); } }
        __syncthreads();
#pragma unroll
        for (int te = 0; te < 4; ++te) { u32x2 o2; o2.x = pk2c(sacc[te][0], sacc[te][1]); o2.y = pk2c(sacc[te][2], sacc[te][3]);
            *(LAS u32x2*)(STT + (16 * te + l15) * SQ + 16 * w + 4 * l4) = o2; }
        { const int i = F.tid >> 3, c8 = (F.tid & 7) * 8;
          *(u32x4*)(OD + (size_t)step_row(n * 64 + i, b, d) * 1024 + c8) = *(const LAS u32x4*)(OS + i * ST_ + c8); }
            }
        { const int n = n2 + 1;

        float k0[8], k1[8], g0[8], g1[8]; float run0 = 0.f, run1 = 0.f;
#pragma unroll
        for (int i = 0; i < 8; ++i) { const float la = bflo(rfB[i]), lc = bfhi(rfB[i]);
            run0 += la; run1 += lc; g0[i] = run0; g1[i] = run1; k0[i] = 1.0f - __builtin_amdgcn_exp2f(la); k1[i] = 1.0f - __builtin_amdgcn_exp2f(lc); }
        *(LAS f32x2*)(CSQ + w * 128 + 2 * dp) = (f32x2){run0, run1};
        { u32x4 wv; wv.x = (unsigned)rvB[0] | ((unsigned)rvB[1] << 16); wv.y = (unsigned)rvB[2] | ((unsigned)rvB[3] << 16); wv.z = (unsigned)rvB[4] | ((unsigned)rvB[5] << 16); wv.w = (unsigned)rvB[6] | ((unsigned)rvB[7] << 16);
          *(LAS u32x4*)(VT + F.lane * ST_ + 8 * w) = wv; }
        __syncthreads();
        float off0 = 0.f, off1 = 0.f, gl0 = 0.f, gl1 = 0.f;
#pragma unroll
        for (int q = 0; q < 8; ++q) { const f32x2 c = *(const LAS f32x2*)(CSQ + q * 128 + 2 * dp); off0 += (q < w) ? c[0] : 0.f; off1 += (q < w) ? c[1] : 0.f; gl0 += c[0]; gl1 += c[1]; }
        const float dc0 = __builtin_amdgcn_exp2f(gl0), dc1 = __builtin_amdgcn_exp2f(gl1);
        if (w == 0) *(LAS f32x2*)(DEC + 2 * dp) = (f32x2){dc0, dc1};
        unsigned kl0[4], kl1[4];
#pragma unroll
        for (int i = 0; i < 8; ++i) {
            const float en0 = __builtin_amdgcn_exp2f(fminf(-(off0 + g0[i]), 115.f)), en1 = __builtin_amdgcn_exp2f(fminf(-(off1 + g1[i]), 115.f));
            const float kg0 = k0[i] * en0, kg1 = k1[i] * en1;
            const float qg0 = bflo(rqB[i]) * __builtin_amdgcn_rcpf(en0), qg1 = bfhi(rqB[i]) * __builtin_amdgcn_rcpf(en1);
            *(LAS unsigned*)(QG + (8 * w + i) * SQ + 2 * dp) = pk2c(qg0, qg1); *(LAS unsigned*)(KG + (8 * w + i) * SQ + 2 * dp) = pk2c(kg0, kg1);
            const unsigned a = pk2c(kg0 * dc0, kg1 * dc1);
            if (i & 1) { kl0[i >> 1] |= a << 16; kl1[i >> 1] |= a & 0xffff0000u; } else { kl0[i >> 1] = a & 0xffffu; kl1[i >> 1] = a >> 16; } }
        *(LAS u32x4*)(KLT + (2 * dp) * ST_ + 8 * w) = (u32x4){kl0[0], kl0[1], kl0[2], kl0[3]};
        *(LAS u32x4*)(KLT + (2 * dp + 1) * ST_ + 8 * w) = (u32x4){kl1[0], kl1[1], kl1[2], kl1[3]};
        __syncthreads();
        if (n + 2 < KSEQ / 64) HG_LOAD(n + 2, rfB, rqB, rvB);
#pragma unroll
        for (int tt = 0; tt < 2; ++tt) { const int t = w + 8 * tt, ti = t >> 2, tj = t & 3;
            f32x4 acc = (f32x4){0.f, 0.f, 0.f, 0.f};
            if (tj <= ti) {
#pragma unroll
                for (int ks = 0; ks < 4; ++ks) { const bf16x8 a = *(const LAS bf16x8*)(QG + (16 * ti + l15) * SQ + ks * 32 + 8 * l4), bb = *(const LAS bf16x8*)(KG + (16 * tj + l15) * SQ + ks * 32 + 8 * l4);
                    acc = __builtin_amdgcn_mfma_f32_16x16x32_bf16(a, bb, acc, 0, 0, 0); } }
#pragma unroll
            for (int r = 0; r < 4; ++r) { const int i = 16 * ti + 4 * l4 + r, j = 16 * tj + l15; ATT[i * ST_ + j] = (j <= i) ? (bf16_t)pk2c(acc[r], 0.f) : (bf16_t)0; } }
        __syncthreads();
#pragma unroll
        for (int tt = 0; tt < 2; ++tt) { const int t = w + 8 * tt, ti = t >> 2, te = t & 3;
            f32x4 acc = (f32x4){0.f, 0.f, 0.f, 0.f};
#pragma unroll
            for (int ks = 0; ks < 4; ++ks) { const bf16x8 a = *(const LAS bf16x8*)(QG + (16 * ti + l15) * SQ + ks * 32 + 8 * l4), bb = *(const LAS bf16x8*)(STT + (16 * te + l15) * SQ + ks * 32 + 8 * l4);
                acc = __builtin_amdgcn_mfma_f32_16x16x32_bf16(a, bb, acc, 0, 0, 0); }
#pragma unroll
            for (int ks = 0; ks < 2; ++ks) { const bf16x8 a = *(const LAS bf16x8*)(ATT + (16 * ti + l15) * ST_ + ks * 32 + 8 * l4), bb = *(const LAS bf16x8*)(VT + (16 * te + l15) * ST_ + ks * 32 + 8 * l4);
                acc = __builtin_amdgcn_mfma_f32_16x16x32_bf16(a, bb, acc, 0, 0, 0); }
#pragma unroll
            for (int r = 0; r < 4; ++r) OS[(16 * ti + 4 * l4 + r) * ST_ + 16 * te + l15] = (bf16_t)pk2c(acc[r], 0.f); }
        { float dc[4];
#pragma unroll
          for (int r = 0; r < 4; ++r) dc[r] = DEC[16 * w + 4 * l4 + r];
          bf16x8 a0 = *(const LAS bf16x8*)(KLT + (16 * w + l15) * ST_ + 8 * l4), a1 = *(const LAS bf16x8*)(KLT + (16 * w + l15) * ST_ + 32 + 8 * l4);
#pragma unroll
          for (int te = 0; te < 4; ++te) {
#pragma unroll
              for (int r = 0; r < 4; ++r) sacc[te][r] *= dc[r];
              const bf16x8 b0 = *(const LAS bf16x8*)(VT + (16 * te + l15) * ST_ + 8 * l4), b1 = *(const LAS bf16x8*)(VT + (16 * te + l15) * ST_ + 32 + 8 * l4);
              sacc[te] = __builtin_amdgcn_mfma_f32_16x16x32_bf16(a0, b0, sacc[te], 0, 0, 0);
              sacc[te] = __builtin_amdgcn_mfma_f32_16x16x32_bf16(a1, b1, sacc[te], 0, 0, 0); } }
        __syncthreads();
#pragma unroll
        for (int te = 0; te < 4; ++te) { u32x2 o2; o2.x = pk2c(sacc[te][0], sacc[te][1]); o2.y = pk2c(sacc[te][2], sacc[te][3]);
            *(LAS u32x2*)(STT + (16 * te + l15) * SQ + 16 * w + 4 * l4) = o2; }
        { const int i = F.tid >> 3, c8 = (F.tid & 7) * 8;
          *(u32x4*)(OD + (size_t)step_row(n * 64 + i, b, d) * 1024 + c8) = *(const LAS u32x4*)(OS + i * ST_ + c8); }
            }
    }
    __builtin_amdgcn_s_setprio(0);
#undef HG_LOAD
}
constexpr int U1_CQ = 0, U1_Z = 512, U1_CKV = 1536, U1_XBC = 2048, U1_KR = 3584, U1_DT = 3648;

__device__ __forceinline__ void phase_l1_prep(const Frame& F) {
    const bf16_t* U1 = F.w<const bf16_t>(WS_U1);
    const f32x2* rope = F.w<const f32x2>(WS_ROPE);
    for (int r = F.gw(); r < R; r += F.ngw()) {
        const bf16_t* ur = U1 + (size_t)r * ODN;
        int b, t, T, rowbase, pos;
        if (r < RL) { b = r >> 12; t = r & 4095; T = TL; rowbase = b * TL; pos = TC + t; } else { const int rc = r - RL; b = rc >> 8; t = rc & 255; T = TC; rowbase = RL + b * TC; pos = t; }
        { float o[8]; float sq = 0.f, sk = 0.f;
          unpack8(*(const u32x4*)(ur + U1_CKV + F.lane * 8), o);
#pragma unroll
          for (int q = 0; q < 8; ++q) sk += o[q] * o[q];
          if (r < RL) { unpack8(*(const u32x4*)(ur + U1_CQ + F.lane * 8), o);
#pragma unroll
              for (int q = 0; q < 8; ++q) sq += o[q] * o[q]; }
          sk = wave_sum(sk); sq = wave_sum(sq);
          if (F.lane == 0) { F.w<float>(WS_RINV)[r] = rsqrtf(sq * (1.0f / 512.0f) + EPS); F.w<float>(WS_RINV)[R + r] = rsqrtf(sk * (1.0f / 512.0f) + EPS); } }
        if (F.lane < 32) { const unsigned w = *(const unsigned*)(ur + U1_KR + 2 * F.lane); float t1 = bflo(w), t2 = bfhi(w);
            if (r < RL) { const f32x2 cs = rope[t * 32 + F.lane]; const float a = t1 * cs[0] - t2 * cs[1], c = t1 * cs[1] + t2 * cs[0]; t1 = a; t2 = c; }
            const unsigned o = pk2(t1, t2);
#pragma unroll
            for (int h = 0; h < 8; ++h) *(unsigned*)(F.w<bf16_t>(WS_KF) + ((size_t)((b * 8 + h) * KSEQ + pos)) * 192 + 128 + 2 * F.lane) = o; }
#pragma unroll
        for (int j = 0; j < 3; ++j) { const int c = (j * 64 + F.lane) * 8; float a[8];
#pragma unroll
            for (int q = 0; q < 8; ++q) a[q] = F.in[I_SCB][c + q];
#pragma unroll
            for (int k = 0; k < 4; ++k) { const int tt = t + k - 2; if (tt < 0 || tt >= T) continue; float o[8]; unpack8(*(const u32x4*)(U1 + (size_t)(rowbase + tt) * ODN + U1_XBC + c), o);
                const f32x4 w0 = *(const f32x4*)(F.in[I_SCW] + k * 1536 + c), w1 = *(const f32x4*)(F.in[I_SCW] + k * 1536 + c + 4);
                a[0] += w0[0] * o[0]; a[1] += w0[1] * o[1]; a[2] += w0[2] * o[2]; a[3] += w0[3] * o[3]; a[4] += w1[0] * o[4]; a[5] += w1[1] * o[5]; a[6] += w1[2] * o[6]; a[7] += w1[3] * o[7]; }
            u32x4 xw; xw.x = pk2c(siluf_(a[0]), siluf_(a[1])); xw.y = pk2c(siluf_(a[2]), siluf_(a[3])); xw.z = pk2c(siluf_(a[4]), siluf_(a[5])); xw.w = pk2c(siluf_(a[6]), siluf_(a[7]));
            *(u32x4*)(F.w<bf16_t>(WS_XBC) + (size_t)r * 1536 + c) = xw; }
        if (F.lane < 32) { const float raw = bf2f(ur[U1_DT + F.lane]); F.w<float>(WS_DT)[(size_t)r * 32 + F.lane] = softplusf_(raw + F.in[I_SDTB][F.lane]); }
    }
}

__device__ __forceinline__ void ssd_scan_unit(const Frame& F, int u) {
    const int b = u >> 5, d = (u >> 4) & 1, h = u & 15, g = h >> 3;
    LAS float* BS = (LAS float*)F.lds;
    LAS float* CS = BS + 32 * 128;
    LAS float* XD = CS + 32 * 128;
    LAS float* DEC = XD + 32 * 64;
    LAS float* YP = DEC + 64;
    const float* XBC = F.w<const float>(WS_XBC); const float* DT = F.w<const float>(WS_DT);
    const float a = -__expf(F.in[I_SALOG][d * 16 + h]);
    bf16_t* YS = F.w<bf16_t>(WS_YS) + (size_t)d * RL * 1024 + h * 64;
    const int si = F.tid >> 4, c8 = (F.tid & 15) * 8;
    const int xi = F.tid >> 4, x4 = (F.tid & 15) * 4;
    f32x4 rb0, rb1, rc0, rc1, rx; float rdt;
#define SSD_LOAD(s0) do { const size_t ro = (size_t)step_row((s0) + si, b, d); const float* xr = XBC + ro * 1536; \
        rb0 = *(const f32x4*)(xr + 1024 + g * 128 + c8); rb1 = *(const f32x4*)(xr + 1024 + g * 128 + c8 + 4); rc0 = *(const f32x4*)(xr + 1280 + g * 128 + c8); rc1 = *(const f32x4*)(xr + 1280 + g * 128 + c8 + 4); \
        rx = *(const f32x4*)(xr + h * 64 + x4); rdt = DT[ro * 32 + d * 16 + h]; } while (0)
    SSD_LOAD(0);
    float S[16];
#pragma unroll
    for (int i = 0; i < 16; ++i) S[i] = 0.f;
#pragma unroll 1
    for (int blk = 0; blk < KSEQ / 32; ++blk) {
        *(LAS f32x4*)(BS + si * 128 + c8) = rb0; *(LAS f32x4*)(BS + si * 128 + c8 + 4) = rb1; *(LAS f32x4*)(CS + si * 128 + c8) = rc0; *(LAS f32x4*)(CS + si * 128 + c8 + 4) = rc1;
        *(LAS f32x4*)(XD + xi * 64 + x4) = rx * rdt; if ((F.tid & 15) == 0) DEC[si] = __expf(rdt * a);
        __syncthreads();
        if (blk + 1 < KSEQ / 32) SSD_LOAD((blk + 1) * 32);
#pragma unroll 2
        for (int i = 0; i < 32; ++i) {
            const LAS f32x4* bp = (const LAS f32x4*)(BS + i * 128 + F.wave * 16); const LAS f32x4* cp = (const LAS f32x4*)(CS + i * 128 + F.wave * 16);
            const float xd = XD[i * 64 + F.lane], de = DEC[i]; float y = 0.f;
#pragma unroll
            for (int gq = 0; gq < 4; ++gq) { const f32x4 b4 = bp[gq], c4 = cp[gq];
#pragma unroll
                for (int q = 0; q < 4; ++q) { float s_ = S[4 * gq + q]; s_ = de * s_ + xd * b4[q]; S[4 * gq + q] = s_; y += c4[q] * s_; } }
            YP[(i * 8 + F.wave) * 64 + F.lane] = y;
        }
        __syncthreads();
        if (blk >= TC / 32) { const int i = F.tid >> 4, p4 = (F.tid & 15) * 4; f32x4 acc = (f32x4){0.f, 0.f, 0.f, 0.f};
#pragma unroll
            for (int w = 0; w < 8; ++w) acc += *(const LAS f32x4*)(YP + (i * 8 + w) * 64 + p4);
            u32x2 o2; o2.x = pk2(acc[0], acc[1]); o2.y = pk2(acc[2], acc[3]);
            *(u32x2*)(YS + (size_t)step_row(blk * 32 + i, b, d) * 1024 + p4) = o2; }
    }
#undef SSD_LOAD
}

__device__ __forceinline__ void phase_mix1_finish(const Frame& F) {
    const bf16_t* U1 = F.w<const bf16_t>(WS_U1); const bf16_t* YS = F.w<const bf16_t>(WS_YS); const bf16_t* XBC = F.w<const bf16_t>(WS_XBC);
    for (int r = F.gw(); r < RL; r += F.ngw()) {
#pragma unroll
        for (int gq = 0; gq < 2; ++gq) { const int c = gq * 512 + F.lane * 8, h = c >> 6; float yf[8], yb[8], z[8];
            unpack8(*(const u32x4*)(YS + (size_t)r * 1024 + c), yf); unpack8(*(const u32x4*)(YS + ((size_t)RL + r) * 1024 + c), yb); unpack8(*(const u32x4*)(U1 + (size_t)r * ODN + U1_Z + c), z);
            float xs[8]; unpack8(*(const u32x4*)(XBC + (size_t)r * 1536 + c), xs); const float dsk = F.in[I_SD][h];
            float y[8], ss = 0.f;
#pragma unroll
            for (int q = 0; q < 8; ++q) { y[q] = (yf[q] + yb[q] + dsk * xs[q]) * siluf_(z[q]); ss += y[q] * y[q]; }
            const float rinv = rsqrtf(wave_sum(ss) * (1.0f / 512.0f) + EPS);
#pragma unroll
            for (int q = 0; q < 8; ++q) y[q] = y[q] * rinv * F.in[I_SON][c + q];
            u32x4 w; w.x = pk2(y[0], y[1]); w.y = pk2(y[2], y[3]); w.z = pk2(y[4], y[5]); w.w = pk2(y[6], y[7]);
            *(u32x4*)(F.w<bf16_t>(WS_Y) + (size_t)r * D + 1024 + c) = w; }
    }
}
__device__ __forceinline__ void ssd_chunk_unit(const Frame& F, int u) {
    const int b = u >> 5, d = (u >> 4) & 1, h = u & 15, g = h >> 3;
    constexpr int SQ = 136, ST_ = 72;
    LAS bf16_t* CM = (LAS bf16_t*)F.lds;
    LAS bf16_t* BM = CM + 64 * SQ;
    LAS bf16_t* BWT = BM + 64 * SQ;
    LAS bf16_t* XT = BWT + 128 * ST_;
    LAS bf16_t* STT = XT + 64 * ST_;
    LAS bf16_t* ATT = STT + 64 * SQ;
    LAS bf16_t* OS = ATT + 64 * ST_;
    LAS float* CSL = (LAS float*)(OS + 64 * ST_);
    LAS float* DTL = CSL + 64;
    const bf16_t* XBC = F.w<const bf16_t>(WS_XBC); const float* DT = F.w<const float>(WS_DT);
    const float a = -__expf(F.in[I_SALOG][d * 16 + h]);
    bf16_t* YS = F.w<bf16_t>(WS_YS) + (size_t)d * RL * 1024 + h * 64;
    const int np = F.lane;
    const int xp = F.tid & 63, xo = F.tid >> 6;
    const int l15 = F.lane & 15, l4 = F.lane >> 4, w = F.wave;
    for (int i = F.tid; i < 64 * SQ / 2; i += NTHR) ((LAS unsigned*)STT)[i] = 0u;
    f32x4 sacc[4];
#pragma unroll
    for (int tp = 0; tp < 4; ++tp) sacc[tp] = (f32x4){0.f, 0.f, 0.f, 0.f};
    unsigned rb[8], rc[8]; unsigned short rx[8]; float rdt = 0.f;
    const long sgn = d ? -1536l : 1536l;
#define SSD_LOAD(n) do { const bf16_t* base = XBC + (size_t)step_row((n) * 64, b, d) * 1536 + (long)(8 * w) * sgn; \
        _Pragma("unroll") for (int i = 0; i < 8; ++i) { const bf16_t* xr = base + (long)i * sgn; rb[i] = *(const unsigned*)(xr + 1024 + g * 128 + 2 * np); rc[i] = *(const unsigned*)(xr + 1280 + g * 128 + 2 * np); rx[i] = xr[h * 64 + xp]; } \
        if (F.tid < 64) rdt = DT[(size_t)step_row((n) * 64 + F.tid, b, d) * 32 + d * 16 + h]; } while (0)
    SSD_LOAD(0);
    if (w >= 4) __builtin_amdgcn_s_setprio(1);
#pragma unroll 1
    for (int n = 0; n < KSEQ / 64; ++n) {
        if (F.tid < 64) { float c = rdt * a;
#pragma unroll
            for (int o = 1; o < 64; o <<= 1) { const float t = __shfl_up(c, o); if (F.lane >= o) c += t; }
            CSL[F.tid] = c; DTL[F.tid] = rdt; }
#pragma unroll
        for (int i = 0; i < 8; ++i) { *(LAS unsigned*)(CM + (8 * w + i) * SQ + 2 * np) = rc[i]; *(LAS unsigned*)(BM + (8 * w + i) * SQ + 2 * np) = rb[i]; }
        __syncthreads();
        const float cslast = CSL[63];
        { unsigned b0[4], b1[4];
#pragma unroll
          for (int i = 0; i < 8; ++i) { const float wgt = __expf(cslast - CSL[8 * w + i]); const unsigned a2 = pk2c(bflo(rb[i]) * wgt, bfhi(rb[i]) * wgt);
              if (i & 1) { b0[i >> 1] |= a2 << 16; b1[i >> 1] |= a2 & 0xffff0000u; } else { b0[i >> 1] = a2 & 0xffffu; b1[i >> 1] = a2 >> 16; } }
          *(LAS u32x4*)(BWT + (2 * np) * ST_ + 8 * w) = (u32x4){b0[0], b0[1], b0[2], b0[3]};
          *(LAS u32x4*)(BWT + (2 * np + 1) * ST_ + 8 * w) = (u32x4){b1[0], b1[1], b1[2], b1[3]};
          u32x4 xv; xv.x = pk2c(bf2f(rx[0]) * DTL[8 * xo + 0], bf2f(rx[1]) * DTL[8 * xo + 1]); xv.y = pk2c(bf2f(rx[2]) * DTL[8 * xo + 2], bf2f(rx[3]) * DTL[8 * xo + 3]);
          xv.z = pk2c(bf2f(rx[4]) * DTL[8 * xo + 4], bf2f(rx[5]) * DTL[8 * xo + 5]); xv.w = pk2c(bf2f(rx[6]) * DTL[8 * xo + 6], bf2f(rx[7]) * DTL[8 * xo + 7]);
          *(LAS u32x4*)(XT + xp * ST_ + 8 * xo) = xv; }
        __syncthreads();
        const float dcy = __expf(cslast);
        if (n + 1 < KSEQ / 64) SSD_LOAD(n + 1);
#pragma unroll
        for (int tt = 0; tt < 2; ++tt) { const int t = w + 8 * tt, ti = t >> 2, tj = t & 3;
            f32x4 acc = (f32x4){0.f, 0.f, 0.f, 0.f};
            if (tj <= ti) {
#pragma unroll
                for (int ks = 0; ks < 4; ++ks) { const bf16x8 av = *(const LAS bf16x8*)(CM + (16 * ti + l15) * SQ + ks * 32 + 8 * l4), bv = *(const LAS bf16x8*)(BM + (16 * tj + l15) * SQ + ks * 32 + 8 * l4);
                    acc = __builtin_amdgcn_mfma_f32_16x16x32_bf16(bv, av, acc, 0, 0, 0); } }
            const int i = 16 * ti + l15, j0 = 16 * tj + 4 * l4;
            const float csi = CSL[i]; const f32x4 csj = *(const LAS f32x4*)(CSL + j0);
            float e[4];
#pragma unroll
            for (int r = 0; r < 4; ++r) { const float x = acc[r] * __expf(fminf(csi - csj[r], 0.f)); e[r] = (j0 + r <= i) ? x : 0.f; }
            u32x2 o2; o2.x = pk2c(e[0], e[1]); o2.y = pk2c(e[2], e[3]);
            *(LAS u32x2*)(ATT + i * ST_ + j0) = o2; }
        __syncthreads();
#pragma unroll
        for (int tt = 0; tt < 2; ++tt) { const int t = w + 8 * tt, ti = t >> 2, tp = t & 3;
            f32x4 acc = (f32x4){0.f, 0.f, 0.f, 0.f};
#pragma unroll
            for (int ks = 0; ks < 4; ++ks) { const bf16x8 av = *(const LAS bf16x8*)(CM + (16 * ti + l15) * SQ + ks * 32 + 8 * l4), bv = *(const LAS bf16x8*)(STT + (16 * tp + l15) * SQ + ks * 32 + 8 * l4);
                acc = __builtin_amdgcn_mfma_f32_16x16x32_bf16(bv, av, acc, 0, 0, 0); }
            acc *= __expf(CSL[16 * ti + l15]);
#pragma unroll
            for (int ks = 0; ks < 2; ++ks) { const bf16x8 av = *(const LAS bf16x8*)(ATT + (16 * ti + l15) * ST_ + ks * 32 + 8 * l4), bv = *(const LAS bf16x8*)(XT + (16 * tp + l15) * ST_ + ks * 32 + 8 * l4);
                acc = __builtin_amdgcn_mfma_f32_16x16x32_bf16(bv, av, acc, 0, 0, 0); }
            u32x2 o2; o2.x = pk2c(acc[0], acc[1]); o2.y = pk2c(acc[2], acc[3]);
            *(LAS u32x2*)(OS + (16 * ti + l15) * ST_ + 16 * tp + 4 * l4) = o2; }
        { const bf16x8 a0 = *(const LAS bf16x8*)(BWT + (16 * w + l15) * ST_ + 8 * l4), a1 = *(const LAS bf16x8*)(BWT + (16 * w + l15) * ST_ + 32 + 8 * l4);
#pragma unroll
          for (int tp = 0; tp < 4; ++tp) { sacc[tp] *= dcy;
              const bf16x8 b0 = *(const LAS bf16x8*)(XT + (16 * tp + l15) * ST_ + 8 * l4), b1 = *(const LAS bf16x8*)(XT + (16 * tp + l15) * ST_ + 32 + 8 * l4);
              sacc[tp] = __builtin_amdgcn_mfma_f32_16x16x32_bf16(a0, b0, sacc[tp], 0, 0, 0);
              sacc[tp] = __builtin_amdgcn_mfma_f32_16x16x32_bf16(a1, b1, sacc[tp], 0, 0, 0); } }
        __syncthreads();
#pragma unroll
        for (int tp = 0; tp < 4; ++tp) { u32x2 o2; o2.x = pk2c(sacc[tp][0], sacc[tp][1]); o2.y = pk2c(sacc[tp][2], sacc[tp][3]);
            *(LAS u32x2*)(STT + (16 * tp + l15) * SQ + 16 * w + 4 * l4) = o2; }
        if (n >= TC / 64) { const int i = F.tid >> 3, c8 = (F.tid & 7) * 8;
            *(u32x4*)(YS + (size_t)step_row(n * 64 + i, b, d) * 1024 + c8) = *(const LAS u32x4*)(OS + i * ST_ + c8); }
    }
    __builtin_amdgcn_s_setprio(0);
#undef SSD_LOAD
}
namespace att {
constexpr int DQ = 192, DV = 128, NW = 8, QBLK = 32, KVBLK = 64;
constexpr float SCALE = 0.07216878364870322f;
constexpr float THR = 8.f;
constexpr int KROW = 400;
constexpr int SHM_V = KVBLK * DV * 2, SHM_K = KVBLK * KROW, SHM_ATTN = 2 * SHM_V + 2 * SHM_K + NW * 64 * 4;
#define KSWZ(row, colB) ((row) * KROW + (colB))
#define SBAR() __builtin_amdgcn_sched_barrier(0)
__device__ __forceinline__ int crow(int r, int hi) { return (r & 3) + 8 * (r >> 2) + 4 * hi; }
__device__ __forceinline__ void partialSM(f32x16& p0, f32x16& p1, float& m_reg, float& mn, float& alpha) {
  constexpr float C = SCALE * 1.4426950408889634f;
  float pmax = p0[0];
#pragma unroll
  for (int r = 1; r < 16; ++r) pmax = fmaxf(pmax, p0[r]);
#pragma unroll
  for (int r = 0; r < 16; ++r) pmax = fmaxf(pmax, p1[r]);
  { auto rr = __builtin_amdgcn_permlane32_swap(__float_as_uint(pmax), __float_as_uint(pmax), false, false);
    pmax = fmaxf(__uint_as_float(rr[0]), __uint_as_float(rr[1])); }
  if (__builtin_expect(__all(pmax - m_reg <= THR / SCALE), 1)) { mn = m_reg; alpha = 1.f; }
  else { mn = fmaxf(m_reg, pmax); alpha = __builtin_amdgcn_exp2f((m_reg - mn) * C); m_reg = mn; }
  float mnC = -mn * C;
#pragma unroll
  for (int r = 0; r < 16; ++r) p0[r] = fmaf(p0[r], C, mnC);
#pragma unroll
  for (int r = 0; r < 16; ++r) p1[r] = fmaf(p1[r], C, mnC);
#pragma unroll
  for (int r = 0; r < 16; ++r) p0[r] = __builtin_amdgcn_exp2f(p0[r]);
}
__device__ __forceinline__ void finishSM(f32x16& p0, f32x16& p1, float alpha, float& l_reg, bf16x8& pa0, bf16x8& pa1, bf16x8& pa2, bf16x8& pa3) {
#pragma unroll
  for (int r = 0; r < 16; ++r) p1[r] = __builtin_amdgcn_exp2f(p1[r]);
  float ps = 0;
#pragma unroll
  for (int r = 0; r < 16; ++r) ps += p0[r];
#pragma unroll
  for (int r = 0; r < 16; ++r) ps += p1[r];
  { auto rr = __builtin_amdgcn_permlane32_swap(__float_as_uint(ps), __float_as_uint(ps), false, false);
    ps = __uint_as_float(rr[0]) + __uint_as_float(rr[1]); }
  l_reg = l_reg * alpha + ps;
#define PK4(P, BASE, OUT) do { unsigned a0 = pk2(P[BASE + 0], P[BASE + 1]), a1 = pk2(P[BASE + 2], P[BASE + 3]);   \
    unsigned b0 = pk2(P[BASE + 4], P[BASE + 5]), b1 = pk2(P[BASE + 6], P[BASE + 7]);                              \
    auto r0 = __builtin_amdgcn_permlane32_swap(a0, b0, false, false); auto r1 = __builtin_amdgcn_permlane32_swap(a1, b1, false, false); \
    u32x4 w = {r0[0], r1[0], r0[1], r1[1]}; OUT = *reinterpret_cast<bf16x8*>(&w); } while (0)
  PK4(p0, 0, pa0); PK4(p0, 8, pa1); PK4(p1, 0, pa2); PK4(p1, 8, pa3);
#undef PK4
}
__device__ __forceinline__ void qkt(f32x16& p0, f32x16& p1, const char* Ks, const bf16x8* qr, int r32, int hi) {
  p0 = f32x16{}; p1 = f32x16{};
#pragma unroll
  for (int d0 = 0; d0 < 12; ++d0) { int cb = (d0 * 16 + hi * 8) * 2;
    bf16x8 b0 = *reinterpret_cast<const bf16x8*>(Ks + KSWZ(r32, cb));
    bf16x8 b1 = *reinterpret_cast<const bf16x8*>(Ks + KSWZ(32 + r32, cb));
    p0 = __builtin_amdgcn_mfma_f32_32x32x16_bf16(b0, qr[d0], p0, 0, 0, 0);
    p1 = __builtin_amdgcn_mfma_f32_32x32x16_bf16(b1, qr[d0], p1, 0, 0, 0); }
}
__device__ __forceinline__ int v_st(int k, int c) { const int kk = (k & ~0xC) | ((k & 4) << 1) | ((k & 8) >> 1); return ((kk >> 3) * 4 + (c >> 5)) * 512 + ((kk & 7) * 32 + (c & 31)) * 2; }
__device__ __forceinline__ int v_rd_base(int lane) { return ((lane & 3) << 3) | (((lane >> 2) & 3) << 6) | (((lane >> 4) & 1) << 5) | (((lane >> 5) & 1) << 8); }
constexpr int v_rd_off(int d0, int ks, int half) { return d0 * 512 + ks * 4096 + half * 2048; }
template <int OFF> __device__ __forceinline__ s16x4 tr_read(int vb) {
  s16x4 r; asm volatile("ds_read_b64_tr_b16 %0, %1 offset:%2" : "=&v"(r) : "v"(vb), "i"(OFF) : "memory"); return r;
}
template <int D0> __device__ __forceinline__ void pv_one(f32x16& od, int vb, bf16x8 pa0, bf16x8 pa1, bf16x8 pa2, bf16x8 pa3) {
  const s16x4 l0 = tr_read<v_rd_off(D0, 0, 0)>(vb), h0 = tr_read<v_rd_off(D0, 0, 1)>(vb), l1 = tr_read<v_rd_off(D0, 1, 0)>(vb), h1 = tr_read<v_rd_off(D0, 1, 1)>(vb);
  const s16x4 l2 = tr_read<v_rd_off(D0, 2, 0)>(vb), h2 = tr_read<v_rd_off(D0, 2, 1)>(vb), l3 = tr_read<v_rd_off(D0, 3, 0)>(vb), h3 = tr_read<v_rd_off(D0, 3, 1)>(vb);
  asm volatile("s_waitcnt lgkmcnt(0)" ::: "memory"); SBAR();
#define PK(L, H) (bf16x8){L[0], L[1], L[2], L[3], H[0], H[1], H[2], H[3]}
  od = __builtin_amdgcn_mfma_f32_32x32x16_bf16(pa0, PK(l0, h0), od, 0, 0, 0);
  od = __builtin_amdgcn_mfma_f32_32x32x16_bf16(pa1, PK(l1, h1), od, 0, 0, 0);
  od = __builtin_amdgcn_mfma_f32_32x32x16_bf16(pa2, PK(l2, h2), od, 0, 0, 0);
  od = __builtin_amdgcn_mfma_f32_32x32x16_bf16(pa3, PK(l3, h3), od, 0, 0, 0);
#undef PK
}
__device__ __forceinline__ void pv_d0(f32x16* o, int vb, bf16x8 pa0, bf16x8 pa1, bf16x8 pa2, bf16x8 pa3) {
  pv_one<0>(o[0], vb, pa0, pa1, pa2, pa3); pv_one<1>(o[1], vb, pa0, pa1, pa2, pa3); pv_one<2>(o[2], vb, pa0, pa1, pa2, pa3); pv_one<3>(o[3], vb, pa0, pa1, pa2, pa3);
}
__device__ __forceinline__ void pv_all(f32x16* o, int vb, bf16x8 pa0, bf16x8 pa1, bf16x8 pa2, bf16x8 pa3) {
  s16x4 l[4][4], h[4][4];
#define RD(D0) l[D0][0] = tr_read<v_rd_off(D0, 0, 0)>(vb); h[D0][0] = tr_read<v_rd_off(D0, 0, 1)>(vb); l[D0][1] = tr_read<v_rd_off(D0, 1, 0)>(vb); h[D0][1] = tr_read<v_rd_off(D0, 1, 1)>(vb); \
               l[D0][2] = tr_read<v_rd_off(D0, 2, 0)>(vb); h[D0][2] = tr_read<v_rd_off(D0, 2, 1)>(vb); l[D0][3] = tr_read<v_rd_off(D0, 3, 0)>(vb); h[D0][3] = tr_read<v_rd_off(D0, 3, 1)>(vb);
  RD(0) RD(1) RD(2) RD(3)
#undef RD
  asm volatile("s_waitcnt lgkmcnt(0)" ::: "memory"); SBAR();
#define PK(L, H) (bf16x8){L[0], L[1], L[2], L[3], H[0], H[1], H[2], H[3]}
#pragma unroll
  for (int d0 = 0; d0 < 4; ++d0) o[d0] = __builtin_amdgcn_mfma_f32_32x32x16_bf16(pa0, PK(l[d0][0], h[d0][0]), o[d0], 0, 0, 0);
#pragma unroll
  for (int d0 = 0; d0 < 4; ++d0) o[d0] = __builtin_amdgcn_mfma_f32_32x32x16_bf16(pa1, PK(l[d0][1], h[d0][1]), o[d0], 0, 0, 0);
#pragma unroll
  for (int d0 = 0; d0 < 4; ++d0) o[d0] = __builtin_amdgcn_mfma_f32_32x32x16_bf16(pa2, PK(l[d0][2], h[d0][2]), o[d0], 0, 0, 0);
#pragma unroll
  for (int d0 = 0; d0 < 4; ++d0) o[d0] = __builtin_amdgcn_mfma_f32_32x32x16_bf16(pa3, PK(l[d0][3], h[d0][3]), o[d0], 0, 0, 0);
#undef PK
}
template <int SDEPTH>
__device__ __forceinline__ void attn_unit(const bf16_t* __restrict__ Qb, const bf16_t* __restrict__ Kh, const bf16_t* __restrict__ Vh, bf16_t* __restrict__ Ob, int ldo, int seq, char* lds) {
  const int tid = threadIdx.x, wid = tid >> 6, lane = tid & 63, r32 = lane & 31, hi = lane >> 5;
  char* V_lds = lds; char* K_lds = lds + 2 * SHM_V;
  float* ws = (float*)(lds + 2 * SHM_V + 2 * SHM_K) + wid * 64; float* li_l = ws; float* al_l = ws + 32;
  float m_reg = -1e30f, l_reg = 0; f32x16 o[4] = {}; bf16x8 qr[12];
  const bf16_t* Qw = Qb + (long)(wid * QBLK + r32) * DQ + hi * 8;
#pragma unroll
  for (int d0 = 0; d0 < 12; ++d0) qr[d0] = *reinterpret_cast<const bf16x8*>(Qw + d0 * 16);
  const int sr = tid >> 4, sc = (tid & 15) * 8, vst0 = v_st(sr, sc), vst1 = v_st(32 + sr, sc);
  int kro[3], kwo[3];
#pragma unroll
  for (int i = 0; i < 3; ++i) { const int p = tid + 512 * i, row = p / 24, c8 = (p % 24) * 8; kro[i] = row * DQ + c8; kwo[i] = KSWZ(row, c8 * 2); }
  const int vb0 = (int)(uintptr_t)V_lds + v_rd_base(lane);
  struct { bf16x8 vs0, vs1, ks0, ks1, ks2; } sr_[SDEPTH];
#define SLOAD(i, k0) do { sr_[i].vs0 = *reinterpret_cast<const bf16x8*>(&Vh[(long)((k0) + sr) * DV + sc]); sr_[i].vs1 = *reinterpret_cast<const bf16x8*>(&Vh[(long)((k0) + 32 + sr) * DV + sc]); \
    sr_[i].ks0 = *reinterpret_cast<const bf16x8*>(&Kh[(long)(k0) * DQ + kro[0]]); sr_[i].ks1 = *reinterpret_cast<const bf16x8*>(&Kh[(long)(k0) * DQ + kro[1]]); sr_[i].ks2 = *reinterpret_cast<const bf16x8*>(&Kh[(long)(k0) * DQ + kro[2]]); } while (0)
#define SWRITE(b, i) do { *(bf16x8*)(V_lds + (b) * SHM_V + vst0) = sr_[i].vs0; *(bf16x8*)(V_lds + (b) * SHM_V + vst1) = sr_[i].vs1; \
    *(bf16x8*)(K_lds + (b) * SHM_K + kwo[0]) = sr_[i].ks0; *(bf16x8*)(K_lds + (b) * SHM_K + kwo[1]) = sr_[i].ks1; *(bf16x8*)(K_lds + (b) * SHM_K + kwo[2]) = sr_[i].ks2; } while (0)
#define SWAIT() do { if constexpr (SDEPTH == 2) asm volatile("s_waitcnt vmcnt(5)" ::: "memory"); else asm volatile("s_waitcnt vmcnt(0)" ::: "memory"); } while (0)
#define RESC(a) do { if (__any((a) < 1.f)) { if (hi == 0) al_l[r32] = (a); asm volatile("s_waitcnt lgkmcnt(0)" ::: "memory"); \
    _Pragma("unroll") for (int d = 0; d < 4; ++d) _Pragma("unroll") for (int r = 0; r < 16; ++r) o[d][r] *= al_l[crow(r, hi)]; } } while (0)
  f32x16 p0, p1; float mn, al; bf16x8 pa0, pa1, pa2, pa3; const int NT = seq / KVBLK;
  SLOAD(0, 0); asm volatile("s_waitcnt vmcnt(0)" ::: "memory"); SWRITE(0, 0);
#pragma unroll 1
  for (int j = 0; j < NT; ++j) {
    const int bsel = j & 1;
    __syncthreads();
    if (j + 1 < NT) SLOAD(0, (j + 1) * KVBLK);
    SBAR(); qkt(p0, p1, K_lds + bsel * SHM_K, qr, r32, hi);
    partialSM(p0, p1, m_reg, mn, al);
    finishSM(p0, p1, al, l_reg, pa0, pa1, pa2, pa3); SBAR();
    RESC(al);
    pv_d0(o, vb0 + bsel * (int)SHM_V, pa0, pa1, pa2, pa3);
    if (j + 1 < NT) { asm volatile("s_waitcnt vmcnt(0)" ::: "memory"); SWRITE(bsel ^ 1, 0); }
  }
  if (hi == 0) li_l[r32] = l_reg; asm volatile("s_waitcnt lgkmcnt(0)" ::: "memory");
  float rli[16];
#pragma unroll
  for (int r = 0; r < 16; ++r) rli[r] = __builtin_amdgcn_rcpf(li_l[crow(r, hi)]);
  bf16_t* Ow = Ob + (long)(wid * QBLK) * ldo;
#pragma unroll
  for (int r = 0; r < 16; ++r) { int orow = crow(r, hi);
#pragma unroll
    for (int d0 = 0; d0 < 4; ++d0) Ow[(long)orow * ldo + d0 * 32 + r32] = f2bf(o[d0][r] * rli[r]); }
  __syncthreads();
#undef SLOAD
#undef SWRITE
#undef SWAIT
#undef RESC
}
__device__ __forceinline__ void attn_unit_dma(const bf16_t* __restrict__ Qb, const bf16_t* __restrict__ Kh, const bf16_t* __restrict__ Vh, bf16_t* __restrict__ Ob, int ldo, int seq, char* lds) {
  const int tid = threadIdx.x, wid = __builtin_amdgcn_readfirstlane(tid >> 6), lane = tid & 63, r32 = lane & 31, hi = lane >> 5;
  char* V_lds = lds; char* K_lds = lds + 2 * SHM_V;
  LAS char* ldsl = (LAS char*)lds;
  float* ws = (float*)(lds + 2 * SHM_V + 2 * SHM_K) + wid * 64; float* li_l = ws; float* al_l = ws + 32;
  float m_reg = -1e30f, l_reg = 0; f32x16 o[4] = {}; bf16x8 qr[12];
  const bf16_t* Qw = Qb + (long)(wid * QBLK + r32) * DQ + hi * 8;
#pragma unroll
  for (int d0 = 0; d0 < 12; ++d0) qr[d0] = *reinterpret_cast<const bf16x8*>(Qw + d0 * 16);
  int kso[4], vso[2];
#pragma unroll
  for (int i = 0; i < 4; ++i) { const int p = (i * 512 + tid) % 1600, row = p / 25; int c = p % 25; c = c > 23 ? 23 : c; kso[i] = row * DQ + c * 8; }
#pragma unroll
  for (int i = 0; i < 2; ++i) { const int p = i * 512 + tid, sub = p >> 5, within = p & 31, kk = (sub >> 2) * 8 + (within >> 2), k = (kk & ~0xC) | ((kk & 4) << 1) | ((kk & 8) >> 1), c = (sub & 3) * 32 + (within & 3) * 8; vso[i] = k * DV + c; }
  const int vb0 = (int)(uintptr_t)V_lds + v_rd_base(lane);
#define DMA_TILE(buf, k0) do { \
    _Pragma("unroll") for (int i_ = 0; i_ < 2; ++i_) __builtin_amdgcn_global_load_lds((const unsigned*)(Vh + (long)(k0) * DV + vso[i_]), (LAS unsigned*)(ldsl + (buf) * SHM_V + (i_ * 512 + wid * 64) * 16), 16, 0, 0); \
    _Pragma("unroll") for (int i_ = 0; i_ < 3; ++i_) __builtin_amdgcn_global_load_lds((const unsigned*)(Kh + (long)(k0) * DQ + kso[i_]), (LAS unsigned*)(ldsl + 2 * SHM_V + (buf) * SHM_K + (i_ * 512 + wid * 64) * 16), 16, 0, 0); \
    if (wid == 0) __builtin_amdgcn_global_load_lds((const unsigned*)(Kh + (long)(k0) * DQ + kso[3]), (LAS unsigned*)(ldsl + 2 * SHM_V + (buf) * SHM_K + 1536 * 16), 16, 0, 0); } while (0)
#define RESC(a) do { if (__any((a) < 1.f)) { if (hi == 0) al_l[r32] = (a); asm volatile("s_waitcnt lgkmcnt(0)" ::: "memory"); \
    _Pragma("unroll") for (int d = 0; d < 4; ++d) _Pragma("unroll") for (int r = 0; r < 16; ++r) o[d][r] *= al_l[crow(r, hi)]; } } while (0)
  f32x16 p0, p1; float mn, al; bf16x8 pa0, pa1, pa2, pa3; const int NT = seq / KVBLK;
  DMA_TILE(0, 0);
  if (wid >= 4) __builtin_amdgcn_s_setprio(1);
#pragma unroll 1
  for (int j = 0; j < NT; ++j) {
    const int bsel = j & 1;
    asm volatile("s_waitcnt vmcnt(0)" ::: "memory");
    __syncthreads();
    if (j + 1 < NT) DMA_TILE(bsel ^ 1, (j + 1) * KVBLK);
    SBAR(); qkt(p0, p1, K_lds + bsel * SHM_K, qr, r32, hi);
    partialSM(p0, p1, m_reg, mn, al);
    finishSM(p0, p1, al, l_reg, pa0, pa1, pa2, pa3); SBAR();
    RESC(al);
    pv_all(o, vb0 + bsel * (int)SHM_V, pa0, pa1, pa2, pa3);
  }
  __builtin_amdgcn_s_setprio(0);
  if (hi == 0) li_l[r32] = l_reg; asm volatile("s_waitcnt lgkmcnt(0)" ::: "memory");
  float rli[16];
#pragma unroll
  for (int r = 0; r < 16; ++r) rli[r] = __builtin_amdgcn_rcpf(li_l[crow(r, hi)]);
  bf16_t* Ow = Ob + (long)(wid * QBLK) * ldo;
#pragma unroll
  for (int r = 0; r < 16; ++r) { int orow = crow(r, hi);
#pragma unroll
    for (int d0 = 0; d0 < 4; ++d0) Ow[(long)orow * ldo + d0 * 32 + r32] = f2bf(o[d0][r] * rli[r]); }
  __syncthreads();
#undef DMA_TILE
#undef RESC
}
constexpr int SHM_ATTN3 = 3 * SHM_V + 3 * SHM_K + NW * 64 * 4;
__device__ __forceinline__ void qkt_h(f32x16& p, const char* Ks, const bf16x8* qr, int r32, int hi, int half) {
  p = f32x16{};
#pragma unroll
  for (int d0 = 0; d0 < 12; ++d0) { const int cb = (d0 * 16 + hi * 8) * 2;
    const bf16x8 b0 = *reinterpret_cast<const bf16x8*>(Ks + KSWZ(32 * half + r32, cb));
    p = __builtin_amdgcn_mfma_f32_32x32x16_bf16(b0, qr[d0], p, 0, 0, 0); }
}
__device__ __forceinline__ void partialSM_h(f32x16& p, float& m_reg, float& mn, float& alpha) {
  constexpr float C = SCALE * 1.4426950408889634f;
  float pmax = p[0];
#pragma unroll
  for (int r = 1; r < 16; ++r) pmax = fmaxf(pmax, p[r]);
  { auto rr = __builtin_amdgcn_permlane32_swap(__float_as_uint(pmax), __float_as_uint(pmax), false, false);
    pmax = fmaxf(__uint_as_float(rr[0]), __uint_as_float(rr[1])); }
  if (__builtin_expect(__all(pmax - m_reg <= THR / SCALE), 1)) { mn = m_reg; alpha = 1.f; }
  else { mn = fmaxf(m_reg, pmax); alpha = __builtin_amdgcn_exp2f((m_reg - mn) * C); m_reg = mn; }
  const float mnC = -mn * C;
#pragma unroll
  for (int r = 0; r < 16; ++r) p[r] = fmaf(p[r], C, mnC);
#pragma unroll
  for (int r = 0; r < 8; ++r) p[r] = __builtin_amdgcn_exp2f(p[r]);
}
__device__ __forceinline__ void finishSM_h(f32x16& p, float alpha, float& l_reg, bf16x8& pa0, bf16x8& pa1) {
#pragma unroll
  for (int r = 8; r < 16; ++r) p[r] = __builtin_amdgcn_exp2f(p[r]);
  float ps = 0;
#pragma unroll
  for (int r = 0; r < 16; ++r) ps += p[r];
  { auto rr = __builtin_amdgcn_permlane32_swap(__float_as_uint(ps), __float_as_uint(ps), false, false);
    ps = __uint_as_float(rr[0]) + __uint_as_float(rr[1]); }
  l_reg = l_reg * alpha + ps;
#define PK4(P, BASE, OUT) do { unsigned a0 = pk2(P[BASE + 0], P[BASE + 1]), a1 = pk2(P[BASE + 2], P[BASE + 3]);   \
    unsigned b0 = pk2(P[BASE + 4], P[BASE + 5]), b1 = pk2(P[BASE + 6], P[BASE + 7]);                              \
    auto r0 = __builtin_amdgcn_permlane32_swap(a0, b0, false, false); auto r1 = __builtin_amdgcn_permlane32_swap(a1, b1, false, false); \
    u32x4 w = {r0[0], r1[0], r0[1], r1[1]}; OUT = *reinterpret_cast<bf16x8*>(&w); } while (0)
  PK4(p, 0, pa0); PK4(p, 8, pa1);
#undef PK4
}
template <int D0, int KH> __device__ __forceinline__ void pv_half_one(f32x16& od, int vb, bf16x8 pa0, bf16x8 pa1) {
  const s16x4 l0 = tr_read<v_rd_off(D0, 2 * KH, 0)>(vb), h0 = tr_read<v_rd_off(D0, 2 * KH, 1)>(vb), l1 = tr_read<v_rd_off(D0, 2 * KH + 1, 0)>(vb), h1 = tr_read<v_rd_off(D0, 2 * KH + 1, 1)>(vb);
  asm volatile("s_waitcnt lgkmcnt(0)" ::: "memory"); SBAR();
#define PK(L, H) (bf16x8){L[0], L[1], L[2], L[3], H[0], H[1], H[2], H[3]}
  od = __builtin_amdgcn_mfma_f32_32x32x16_bf16(pa0, PK(l0, h0), od, 0, 0, 0);
  od = __builtin_amdgcn_mfma_f32_32x32x16_bf16(pa1, PK(l1, h1), od, 0, 0, 0);
#undef PK
}
template <int KH> __device__ __forceinline__ void pv_half(f32x16* o, int vb, bf16x8 pa0, bf16x8 pa1) {
  pv_half_one<0, KH>(o[0], vb, pa0, pa1); pv_half_one<1, KH>(o[1], vb, pa0, pa1); pv_half_one<2, KH>(o[2], vb, pa0, pa1); pv_half_one<3, KH>(o[3], vb, pa0, pa1);
}
__device__ __forceinline__ void attn_unit_h(const bf16_t* __restrict__ Qb, const bf16_t* __restrict__ Kh, const bf16_t* __restrict__ Vh, bf16_t* __restrict__ Ob, int ldo, int seq, char* lds) {
  const int tid = threadIdx.x, wid = __builtin_amdgcn_readfirstlane(tid >> 6), lane = tid & 63, r32 = lane & 31, hi = lane >> 5;
  char* V_lds = lds; char* K_lds = lds + 3 * SHM_V;
  LAS char* ldsl = (LAS char*)lds;
  float* ws = (float*)(lds + 3 * SHM_V + 3 * SHM_K) + wid * 64; float* li_l = ws; float* al_l = ws + 32;
  float m_reg = -1e30f, l_reg = 0; f32x16 o[4] = {}; bf16x8 qr[12];
  const bf16_t* Qw = Qb + (long)(wid * QBLK + r32) * DQ + hi * 8;
#pragma unroll
  for (int d0 = 0; d0 < 12; ++d0) qr[d0] = *reinterpret_cast<const bf16x8*>(Qw + d0 * 16);
  int kso[4], vso[2];
#pragma unroll
  for (int i = 0; i < 4; ++i) { const int p = (i * 512 + tid) % 1600, row = p / 25; int c = p % 25; c = c > 23 ? 23 : c; kso[i] = row * DQ + c * 8; }
#pragma unroll
  for (int i = 0; i < 2; ++i) { const int p = i * 512 + tid, sub = p >> 5, within = p & 31, kk = (sub >> 2) * 8 + (within >> 2), k = (kk & ~0xC) | ((kk & 4) << 1) | ((kk & 8) >> 1), c = (sub & 3) * 32 + (within & 3) * 8; vso[i] = k * DV + c; }
  const int vb0 = (int)(uintptr_t)V_lds + v_rd_base(lane);
#define DMA_TILE(buf, k0) do { \
    _Pragma("unroll") for (int i_ = 0; i_ < 2; ++i_) __builtin_amdgcn_global_load_lds((const unsigned*)(Vh + (long)(k0) * DV + vso[i_]), (LAS unsigned*)(ldsl + (buf) * SHM_V + (i_ * 512 + wid * 64) * 16), 16, 0, 0); \
    _Pragma("unroll") for (int i_ = 0; i_ < 3; ++i_) __builtin_amdgcn_global_load_lds((const unsigned*)(Kh + (long)(k0) * DQ + kso[i_]), (LAS unsigned*)(ldsl + 3 * SHM_V + (buf) * SHM_K + (i_ * 512 + wid * 64) * 16), 16, 0, 0); \
    if (wid == 0) __builtin_amdgcn_global_load_lds((const unsigned*)(Kh + (long)(k0) * DQ + kso[3]), (LAS unsigned*)(ldsl + 3 * SHM_V + (buf) * SHM_K + 1536 * 16), 16, 0, 0); } while (0)
#define RESC(a) do { if (__any((a) < 1.f)) { if (hi == 0) al_l[r32] = (a); asm volatile("s_waitcnt lgkmcnt(0)" ::: "memory"); \
    _Pragma("unroll") for (int d = 0; d < 4; ++d) _Pragma("unroll") for (int r = 0; r < 16; ++r) o[d][r] *= al_l[crow(r, hi)]; } } while (0)
#define TILE_SYNC() do { asm volatile("s_waitcnt vmcnt(0)" ::: "memory"); __syncthreads(); } while (0)
  f32x16 pA, pB; float mnA, mnB, alA, alB; bf16x8 pa0, pa1; const int NT = seq / KVBLK;
  DMA_TILE(0, 0); DMA_TILE(1, KVBLK);
  TILE_SYNC();
  DMA_TILE(2, 2 * KVBLK);
  qkt_h(pA, K_lds, qr, r32, hi, 0); partialSM_h(pA, m_reg, mnA, alA);
  SBAR(); qkt_h(pB, K_lds, qr, r32, hi, 1);
  finishSM_h(pA, alA, l_reg, pa0, pa1); SBAR();
  pv_half<0>(o, vb0, pa0, pa1); partialSM_h(pB, m_reg, mnB, alB);
  RESC(alB);
  int bp = 0, bc = 1, bn = 2;
#pragma unroll 1
  for (int j = 1; j < NT; ++j) {
    SBAR(); qkt_h(pA, K_lds + bc * SHM_K, qr, r32, hi, 0);
    finishSM_h(pB, alB, l_reg, pa0, pa1); SBAR();
    pv_half<1>(o, vb0 + bp * (int)SHM_V, pa0, pa1); partialSM_h(pA, m_reg, mnA, alA);
    TILE_SYNC();
    if (j + 2 < NT) DMA_TILE(bp, (j + 2) * KVBLK);
    RESC(alA);
    SBAR(); qkt_h(pB, K_lds + bc * SHM_K, qr, r32, hi, 1);
    finishSM_h(pA, alA, l_reg, pa0, pa1); SBAR();
    pv_half<0>(o, vb0 + bc * (int)SHM_V, pa0, pa1); partialSM_h(pB, m_reg, mnB, alB);
    RESC(alB);
    { const int t0 = bp; bp = bc; bc = bn; bn = t0; }
  }
  finishSM_h(pB, alB, l_reg, pa0, pa1); SBAR();
  pv_half<1>(o, vb0 + bp * (int)SHM_V, pa0, pa1);
  if (hi == 0) li_l[r32] = l_reg; asm volatile("s_waitcnt lgkmcnt(0)" ::: "memory");
  float rli[16];
#pragma unroll
  for (int r = 0; r < 16; ++r) rli[r] = __builtin_amdgcn_rcpf(li_l[crow(r, hi)]);
  bf16_t* Ow = Ob + (long)(wid * QBLK) * ldo;
#pragma unroll
  for (int r = 0; r < 16; ++r) { int orow = crow(r, hi);
#pragma unroll
    for (int d0 = 0; d0 < 4; ++d0) Ow[(long)orow * ldo + d0 * 32 + r32] = f2bf(o[d0][r] * rli[r]); }
  __syncthreads();
#undef DMA_TILE
#undef RESC
#undef TILE_SYNC
}
#undef KSWZ
#undef SBAR
}
#ifndef MK_PER_PHASE
#define MK_PER_PHASE 0
#endif
constexpr int NPH = 25;
#ifndef ATT_SDEPTH
#define ATT_SDEPTH 1
#endif

#ifndef HC_G1
#define HC_G1 240
#define HC_G2 184
#define HC_G3 232
#define HC_G4 232
#define HC_G6 232
#endif
#ifndef HC_L0P4
#define HC_L0P4 17664
#define HC_L0G1 16384
#define HC_L0G2 25600
#define HC_L1P4 23296
#define HC_L1G3 19200
#define HC_L1G4 12288
#define HC_L1G6 6400
#endif
constexpr int L0_P4 = HC_L0P4, L0_G1 = L0_P4 + HC_L0G1, L0_G2 = L0_G1 + HC_L0G2;
constexpr int L1_P4 = HC_L1P4, L1_G3 = L1_P4 + HC_L1G3, L1_G4 = L1_G3 + HC_L1G4, L1_G6 = L1_G4 + HC_L1G6;
static_assert(L0_G2 == PL_LO && L0_G2 <= IT_MOE && L1_G6 <= IT_MOE, "helper plan");
__device__ __forceinline__ void helper_convert(const Frame& F, int GG, int l, int lo, int hi) { moe_convert_range(F, l, lo, hi, (F.bid - GG) * NWAVES + F.wave, (F.G - GG) * NWAVES); }

__device__ __forceinline__ void moe_gemms_gateup(const Frame& F, int l, int tM, int GG) {
    pg8::Gemm g{D, D, D};
    pg8::GroupSched S{(const char*)F.w<bf16_t>(WS_H), (const char*)(F.w<bf16_t>(WS_WGU) + (size_t)l * NE * GUN * D), (size_t)256 * D * 2, (size_t)256 * D * 2, tM, 11, NE, GG, F.bid, F.w<const int>(WS_ROWMAP)};
    EpiGateUp E{F.w<bf16_t>(WS_HID)};
    pg8::gemm_phase<EpiGateUp, pg8::GroupSched, true>(F.lds, g, S, E);
}
__device__ __forceinline__ void moe_gemms_down(const Frame& F, int l, int tM, int GG) {
    pg8::Gemm g{FF, FF, FF};
    pg8::GroupSched S{(const char*)F.w<bf16_t>(WS_HID), (const char*)(F.w<bf16_t>(WS_WDN) + (size_t)l * NE * D * FF), (size_t)256 * FF * 2, (size_t)256 * FF * 2, tM, 8, NE, GG, F.bid, nullptr};
    EpiDown E{F.w<bf16_t>(WS_YE), F.w<const float>(WS_GROW)};
    pg8::gemm_phase(F.lds, g, S, E);
}

__global__ void __launch_bounds__(NTHR, 2) mk_fwd(Params p) {
    extern __shared__ __attribute__((aligned(16))) unsigned char lds_raw[];
    Frame F;
    F.lds = (LAS unsigned char*)lds_raw; F.in = p.in; F.out = p.out; F.ws = p.ws;
    F.tid = threadIdx.x; F.lane = F.tid & 63; F.wave = __builtin_amdgcn_readfirstlane(F.tid >> 6); F.bid = blockIdx.x; F.G = gridDim.x;
    volatile LAS unsigned* MISC = (volatile LAS unsigned*)(F.lds + LDS_MISC);
    if (F.tid < 64) MISC[F.tid] = 0u;
    __syncthreads();
    XcdBarrier bar; bar.bar = (unsigned*)(p.ws + WS_CTL) + 4096; bar.x = 0; bar.st = nullptr;
#if !MK_PER_PHASE
    bar = xcd_barrier_post((unsigned*)(p.ws + WS_CTL) + 4096, MISC + 8);
#endif
    const int lo = p.ph_lo, hi = p.ph_hi;
#ifndef MK_ONLY
#define MK_ONLY -1
#endif
#ifndef MK_DUP
#define MK_DUP 0u
#endif
#define REP(k) for (int rep_ = 0; rep_ <= (int)((MK_DUP >> (k)) & 1u); ++rep_)
#define IN(k) ((MK_ONLY < 0 || MK_ONLY == (k)) && lo <= (k) && (k) < hi)
#if MK_PER_PHASE
#define SEAM(k) do { } while (0)
#else
#define SEAM(k) do { if (IN(k) && hi > (k) + 1) xcd_barrier(bar); } while (0)
#endif

    if (IN(0)) REP(0) { phase_prologue(F); } SEAM(0);
    if (IN(1)) REP(1) { phase_norm0(F); } SEAM(1);
#ifdef MK_XBAR
    for (int xb_ = 0; xb_ < MK_XBAR; ++xb_) xcd_barrier(bar);
#endif
    const bool full = F.G == 256;
    if (IN(2)) REP(2) {
        const int GG = full ? HC_G1 : F.G;
        if (F.bid < GG) {
        pg8::Gemm g{D, D, D};
        pg8::RectSched S{(const char*)F.w<bf16_t>(WS_H), (const char*)F.w<bf16_t>(WS_WEV), (size_t)256 * D * 2, (size_t)256 * D * 2, R / 256, EVN / 256, (R / 256) * (EVN / 256), GG, F.bid};
        EpiEv E{F.w<bf16_t>(WS_U0), F.w<const float>(WS_LB)};
        pg8::gemm_phase(F.lds, g, S, E);
        } else helper_convert(F, GG, 0, L0_P4, L0_G1);
    } SEAM(2);
    if (IN(3)) REP(3) { phase_lru_gates(F); } SEAM(3);
    if (IN(4)) REP(4) { for (int u = F.bid; u < 256; u += F.G) { if (u < 128) { for (int r2 = 0; r2 <= (int)((MK_DUP >> 25) & 1u); ++r2) { hgrn_chunk_unit(F, u); __syncthreads(); } } else { for (int r2 = 0; r2 <= (int)((MK_DUP >> 26) & 1u); ++r2) { lru_scan_unit(F, u - 128); __syncthreads(); } if (F.G == 256) { moe_convert_range(F, 0, 0, L0_P4, (u - 128) * NWAVES + F.wave, 128 * NWAVES); moe_convert_range(F, 1, 0, L1_P4, (u - 128) * NWAVES + F.wave, 128 * NWAVES); } __syncthreads(); } } } SEAM(4);
    if (IN(5)) REP(5) { phase_mix0_finish(F); } SEAM(5);
    if (IN(6)) REP(6) {
        const int GG = full ? HC_G2 : F.G;
        if (F.bid < GG) {
        pg8::Gemm g{D, D, D};
        pg8::RectSched S{(const char*)F.w<bf16_t>(WS_Y), (const char*)F.w<bf16_t>(WS_WO), (size_t)256 * D * 2, (size_t)256 * D * 2, R / 256, D / 256, (R / 256) * (D / 256), GG, F.bid};
        EpiDelta E{F.w<bf16_t>(WS_DELTA), F.w<const float>(WS_MOD)};
        pg8::gemm_phase(F.lds, g, S, E);
        } else helper_convert(F, GG, 0, L0_G1, L0_G2);
    } SEAM(6);
    if (IN(7)) REP(7) { phase_router(F, 0, R); } SEAM(7);
    if (IN(8)) REP(8) { phase_topk(F, 128, MROWS0); } SEAM(8);
    if (IN(10)) REP(10) { const int GG = full ? HC_G3 : F.G; if (F.bid < GG) moe_gemms_gateup(F, 0, MROWS0 / 256, GG); else helper_convert(F, GG, 1, L1_P4, L1_G3); } SEAM(10);
    if (IN(11)) REP(11) { const int GG = full ? HC_G4 : F.G; if (F.bid < GG) moe_gemms_down(F, 0, MROWS0 / 256, GG); else helper_convert(F, GG, 1, L1_G3, L1_G4); } SEAM(11);
    if (IN(12)) REP(12) { phase_combine(F, 0, R, MROWS0, false);
        __syncthreads();
        if (!full) moe_convert_range(F, 1, 0, IT_MOE, F.gw(), F.ngw()); } SEAM(12);
    if (IN(13)) REP(13) {
        pg8::Gemm g{D, D, D};
        const char* A = (const char*)F.w<bf16_t>(WS_H); const char* B = (const char*)F.w<bf16_t>(WS_WOD); const size_t ts = (size_t)256 * D * 2;
        pg8::TwoRectSched S{A, B, A + 64 * ts, B + 6 * ts, ts, ts, RL / 256, ODN / 256, RC / 256, 9, 64, 6, F.G, F.bid};
        EpiStoreBf16 E{F.w<bf16_t>(WS_U1), ODN};
        pg8::gemm_phase(F.lds, g, S, E);
    } SEAM(13);
    if (IN(14)) REP(14) { phase_l1_prep(F); } SEAM(14);
    if (IN(15)) REP(15) {
        const int GG = full ? HC_G6 : F.G;
        if (F.bid < GG) {
        pg8::Gemm g{512, ODN, 512};
        const char* A = (const char*)F.w<bf16_t>(WS_U1);
        pg8::TwoRectSched S{A, (const char*)F.w<bf16_t>(WS_WQ), A + (size_t)U1_CKV * 2, (const char*)F.w<bf16_t>(WS_WKV), (size_t)256 * ODN * 2, (size_t)256 * 512 * 2, RL / 256, 6, R / 256, 8, 0, 0, GG, F.bid};
        EpiMla E{F.w<bf16_t>(WS_Q), F.w<bf16_t>(WS_KF), F.w<bf16_t>(WS_VF), F.w<const float>(WS_RINV), F.w<const f32x2>(WS_ROPE)};
        pg8::gemm_phase(F.lds, g, S, E);
        } else helper_convert(F, GG, 1, L1_G4, L1_G6);
    } SEAM(15);
    if (IN(16)) REP(16) {
        const bf16_t* Q = F.w<const bf16_t>(WS_Q); const bf16_t* KF = F.w<const bf16_t>(WS_KF); const bf16_t* VF = F.w<const bf16_t>(WS_VF); bf16_t* Y = F.w<bf16_t>(WS_Y);
        auto attn = [&](int u) { const int bh = u >> 4, qb = u & 15, b = bh >> 3, h = bh & 7;
            att::attn_unit_dma(Q + ((size_t)bh * TL + qb * 256) * 192, KF + (size_t)bh * KSEQ * 192, VF + (size_t)bh * KSEQ * 128, Y + ((size_t)b * TL + qb * 256) * D + h * 128, D, KSEQ, (char*)lds_raw); };
        for (int u = F.bid; u < 128; u += F.G) for (int r2 = 0; r2 <= (int)((MK_DUP >> 27) & 1u); ++r2) { ssd_chunk_unit(F, u); __syncthreads(); }
        unsigned* qctr = (unsigned*)(p.ws + WS_CTL) + 8192;
        volatile LAS unsigned* qw = MISC + 16;
#pragma unroll 1
        for (;;) {
            if (F.tid == 0) qw[0] = __hip_atomic_fetch_add(qctr, 1u, __ATOMIC_RELAXED, __HIP_MEMORY_SCOPE_AGENT);
            __syncthreads();
            const unsigned u = qw[0];
            __syncthreads();
            if (u >= 512u) break;
            attn((int)u);
        }
        if (full && F.bid < 128) { __syncthreads(); moe_convert_range(F, 1, L1_G6, IT_MOE, F.bid * NWAVES + F.wave, 128 * NWAVES); }
    } SEAM(16);
    if (IN(17)) REP(17) { phase_mix1_finish(F); } SEAM(17);
    if (IN(18)) REP(18) {
        pg8::Gemm g{D, D, D};
        pg8::RectSched S{(const char*)F.w<bf16_t>(WS_Y), (const char*)(F.w<bf16_t>(WS_WO) + (size_t)D * D), (size_t)256 * D * 2, (size_t)256 * D * 2, RL / 256, D / 256, (RL / 256) * (D / 256), F.G, F.bid};
        EpiDelta E{F.w<bf16_t>(WS_DELTA), F.w<const float>(WS_MOD) + 5 * 12288};
        pg8::gemm_phase(F.lds, g, S, E);
    } SEAM(18);
    if (IN(19)) REP(19) { phase_router(F, 1, RL); } SEAM(19);
    if (IN(20)) REP(20) { phase_topk(F, 64, MROWS1); } SEAM(20);
    if (IN(22)) REP(22) { moe_gemms_gateup(F, 1, MROWS1 / 256, F.G); } SEAM(22);
    if (IN(23)) REP(23) { moe_gemms_down(F, 1, MROWS1 / 256, F.G); } SEAM(23);
    if (IN(24)) REP(24) { phase_combine(F, 1, RL, MROWS1, true); }
#undef IN
#undef SEAM
}

extern "C" void kernel_launch(void* const* d_in, const int* in_sizes, int n_in, void* d_out, int out_size, void* d_ws, size_t ws_size, hipStream_t stream) {
    static int grid = 0;
    if (grid == 0) {
        if (n_in != 35 || in_sizes[0] != RL * D || out_size != RL * D || ws_size < WS_END) { fprintf(stderr, "kernel_launch: unexpected shapes (n_in %d, in0 %d, out %d, ws %zu < %zu)\n", n_in, n_in > 0 ? in_sizes[0] : -1, out_size, ws_size, (size_t)WS_END); grid = -1; return; }
        int dev = 0, cus = 0, per_cu = 0;
        if (hipGetDevice(&dev) != hipSuccess || hipDeviceGetAttribute(&cus, hipDeviceAttributeMultiprocessorCount, dev) != hipSuccess) { grid = -1; return; }
        if (hipFuncSetAttribute((const void*)mk_fwd, hipFuncAttributeMaxDynamicSharedMemorySize, LDS_BYTES) != hipSuccess) { fprintf(stderr, "kernel_launch: hipFuncSetAttribute failed\n"); grid = -1; return; }
        if (hipOccupancyMaxActiveBlocksPerMultiprocessor(&per_cu, (const void*)mk_fwd, NTHR, LDS_BYTES) != hipSuccess || per_cu < 1) { fprintf(stderr, "kernel_launch: occupancy query says %d\n", per_cu); }
        (void)hipGetLastError();
        grid = cus;
    }
    if (grid < 0) return;
    (void)hipMemsetAsync((char*)d_ws + WS_CTL, 0, CTL_BYTES, stream);
    Params p; memset(&p, 0, sizeof(p));
    for (int i = 0; i < 35; ++i) p.in[i] = (const float*)d_in[i];
    p.out = (float*)d_out; p.ws = (unsigned char*)d_ws;
#if MK_PER_PHASE
    for (int k = 0; k < NPH; ++k) { p.ph_lo = k; p.ph_hi = k + 1; hipLaunchKernelGGL(mk_fwd, dim3(grid), dim3(NTHR), LDS_BYTES, stream, p); }
#else
    p.ph_lo = 0; p.ph_hi = NPH; hipLaunchKernelGGL(mk_fwd, dim3(grid), dim3(NTHR), LDS_BYTES, stream, p);
#endif
    const hipError_t le = hipPeekAtLastError();
    if (le != hipSuccess) fprintf(stderr, "kernel_launch: launch failed: %s\n", hipGetErrorName(le));
}
```

```cpp
#include <hip/hip_runtime.h>
#include <cstdio>
#include <cstdint>
#include <cstring>

#define LAS __attribute__((address_space(3)))
typedef unsigned short bf16_t;
typedef short bf16x8 __attribute__((ext_vector_type(8)));
typedef short s16x4 __attribute__((ext_vector_type(4)));
typedef float f32x2 __attribute__((ext_vector_type(2)));
typedef float f32x4 __attribute__((ext_vector_type(4)));
typedef float f32x8 __attribute__((ext_vector_type(8)));
typedef float f32x16 __attribute__((ext_vector_type(16)));
typedef unsigned u32x2 __attribute__((ext_vector_type(2)));
typedef unsigned u32x4 __attribute__((ext_vector_type(4)));

constexpr int D = 2048, NB = 4, TL = 4096, TC = 256, RL = NB * TL, RC = NB * TC, R = RL + RC;
constexpr int EVN = 7168, ODN = 3840, ODSRC = 3680;
constexpr int NE = 16, FF = 1408, GUN = 2816, CAPL = 512, CAPC = 32;
constexpr int KSEQ = TC + TL;
constexpr float EPS = 1e-6f;
constexpr int NWAVES = 8, NTHR = 512;
constexpr int MODS = 32;

__device__ __forceinline__ float bf2f(unsigned short b) { return __uint_as_float(((unsigned)b) << 16); }
__device__ __forceinline__ float bflo(unsigned w) { return __uint_as_float(w << 16); }
__device__ __forceinline__ float bfhi(unsigned w) { return __uint_as_float(w & 0xffff0000u); }
__device__ __forceinline__ unsigned short f2bf(float f) { unsigned u = __float_as_uint(f); u += 0x7fffu + ((u >> 16) & 1u); return (unsigned short)(u >> 16); }
typedef __bf16 bf16x2_t __attribute__((ext_vector_type(2)));
__device__ __forceinline__ unsigned pk2c(float lo, float hi) { const bf16x2_t v = __builtin_convertvector((f32x2){lo, hi}, bf16x2_t); return __builtin_bit_cast(unsigned, v); }
__device__ __forceinline__ unsigned pk2(float lo, float hi) { unsigned r; asm volatile("v_cvt_pk_bf16_f32 %0, %1, %2" : "=v"(r) : "v"(lo), "v"(hi)); return r; }
__device__ __forceinline__ float sigmoidf_(float x) { return __builtin_amdgcn_rcpf(1.0f + __expf(-x)); }
__device__ __forceinline__ float siluf_(float x) { return x * __builtin_amdgcn_rcpf(1.0f + __expf(-x)); }
__device__ __forceinline__ float softplusf_(float x) { return x > 20.f ? x : log1pf(__expf(x)); }
__device__ __forceinline__ float gelu_tanh_(float x) { const float u = 0.7978845608028654f * (x + 0.044715f * x * x * x); return x * (1.0f - __builtin_amdgcn_rcpf(1.0f + __expf(2.0f * u))); }
__device__ __forceinline__ float wave_sum(float v) {
#pragma unroll
    for (int o = 1; o < 64; o <<= 1) v += __shfl_xor(v, o);
    return v;
}
__device__ __forceinline__ float wave_max(float v) {
#pragma unroll
    for (int o = 1; o < 64; o <<= 1) v = fmaxf(v, __shfl_xor(v, o));
    return v;
}
#define LDS_WAIT() asm volatile("s_waitcnt lgkmcnt(0)" ::: "memory")
#define VM_WAIT() asm volatile("s_waitcnt vmcnt(0)" ::: "memory")

__device__ __forceinline__ void load_row_f32(const float* row, int lane, float (&v)[32]) {
#pragma unroll
    for (int j = 0; j < 4; ++j) { const f32x4* p = (const f32x4*)(row + (j * 64 + lane) * 8); const f32x4 a = p[0], b = p[1];
        v[8 * j + 0] = a[0]; v[8 * j + 1] = a[1]; v[8 * j + 2] = a[2]; v[8 * j + 3] = a[3]; v[8 * j + 4] = b[0]; v[8 * j + 5] = b[1]; v[8 * j + 6] = b[2]; v[8 * j + 7] = b[3]; }
}
__device__ __forceinline__ void store_row_f32(float* row, int lane, const float (&v)[32]) {
#pragma unroll
    for (int j = 0; j < 4; ++j) { f32x4* p = (f32x4*)(row + (j * 64 + lane) * 8);
        p[0] = (f32x4){v[8 * j + 0], v[8 * j + 1], v[8 * j + 2], v[8 * j + 3]}; p[1] = (f32x4){v[8 * j + 4], v[8 * j + 5], v[8 * j + 6], v[8 * j + 7]}; }
}
__device__ __forceinline__ void store_row_bf16(bf16_t* row, int lane, const float (&v)[32]) {
#pragma unroll
    for (int j = 0; j < 4; ++j) { u32x4 w; w.x = pk2(v[8 * j + 0], v[8 * j + 1]); w.y = pk2(v[8 * j + 2], v[8 * j + 3]); w.z = pk2(v[8 * j + 4], v[8 * j + 5]); w.w = pk2(v[8 * j + 6], v[8 * j + 7]);
        *(u32x4*)(row + (j * 64 + lane) * 8) = w; }
}
__device__ __forceinline__ void load_row_bf16(const bf16_t* row, int lane, float (&v)[32]) {
#pragma unroll
    for (int j = 0; j < 4; ++j) { const u32x4 w = *(const u32x4*)(row + (j * 64 + lane) * 8);
        v[8 * j + 0] = bflo(w.x); v[8 * j + 1] = bfhi(w.x); v[8 * j + 2] = bflo(w.y); v[8 * j + 3] = bfhi(w.y); v[8 * j + 4] = bflo(w.z); v[8 * j + 5] = bfhi(w.z); v[8 * j + 6] = bflo(w.w); v[8 * j + 7] = bfhi(w.w); }
}
__device__ __forceinline__ void unpack8(const u32x4 w, float (&o)[8]) { o[0] = bflo(w.x); o[1] = bfhi(w.x); o[2] = bflo(w.y); o[3] = bfhi(w.y); o[4] = bflo(w.z); o[5] = bfhi(w.z); o[6] = bflo(w.w); o[7] = bfhi(w.w); }
namespace pg8 {
constexpr int BM = 256, BK = 64, HALF = 128, HTB = HALF * BK * 2, STAGE_BYTES = 8 * HTB, NXCD = 8, WGM = 8;
__host__ __device__ __forceinline__ int lds_byte(int r, int c) { const int st = (r >> 4) * 2 + (c >> 5), rr = r & 15, cc = c & 31, ob = rr * 64 + cc * 2; return st * 1024 + (ob ^ (((ob >> 9) & 1) << 5)); }
__host__ __device__ __forceinline__ void stage_rc(int b, int& R_, int& C_) { const int st = b / 1024, sb = b % 1024, swz = sb ^ (((sb >> 9) & 1) << 5); R_ = (st >> 1) * 16 + swz / 64; C_ = (st & 1) * 32 + (swz % 64) / 2; }
__host__ __device__ __forceinline__ int perm32(int rho) { const int n = rho >> 4, i = rho & 15; return 8 * (i >> 2) + 4 * n + (i & 3); }

struct Unit { int pm, pn, z; };
struct Gemm { int K, lda, ldb; };

__device__ __forceinline__ int xcd_remap(int L, int nwg) { const int q = nwg / NXCD, r = nwg % NXCD, xcd = L % NXCD, off = L / NXCD; return (xcd < r ? xcd * (q + 1) : r * (q + 1) + (xcd - r) * q) + off; }
__device__ __forceinline__ void tile_in_rect(int w, int nM, int nN, int& pm, int& pn) {
    const int nig = WGM * nN, gid = w / nig, fm = gid * WGM, gsz = (nM - fm) < WGM ? (nM - fm) : WGM;
    pm = fm + ((w % nig) % gsz); pn = (w % nig) / gsz;
}

#ifndef PG8_SP2
#define PG8_SP2 true
#endif
#ifndef PG8_ALIGN
#define PG8_ALIGN true
#endif
template <class Epi, class Sched, bool GATHER = false, bool ALIGN_EPI = PG8_ALIGN, bool SP2 = PG8_SP2>
__device__ __forceinline__ void gemm_phase(LAS unsigned char* lds, const Gemm g, const Sched& S, const Epi& E) {
    const int tid = threadIdx.x, wid = __builtin_amdgcn_readfirstlane(tid >> 6), lane = tid & 63, wr = wid >> 2, wc = wid & 3, fr = lane & 15, fq = lane >> 4;
    const int K = g.K, nt = K / BK;
    unsigned voffB[2]; int stR[2], stC[2];
#pragma unroll
    for (int i = 0; i < 2; ++i) { int R_, C_; stage_rc(tid * 16 + i * 8192, R_, C_); const int Rb = Epi::PERM ? (Epi::WIDE ? ((R_ >> 5) * 64 + perm32(R_ & 31)) : ((R_ & ~31) + perm32(R_ & 31))) : R_;
        stR[i] = R_; stC[i] = C_; voffB[i] = (unsigned)(Rb * g.ldb + C_) * 2u; }
    unsigned cvA[2][2], nvA[2][2];
    const size_t kstep = (size_t)(BK * 2);
    const size_t hstepB = (size_t)(Epi::WIDE ? 32 : HALF) * g.ldb * 2;
    const unsigned ldsw = (unsigned)wid * 1024u;
    const int aoff = lds_byte(wr * 64 + fr, fq * 8), boff = lds_byte(wc * 32 + fr, fq * 8);
#define PG8_SA(b, h) (((b) * 2 + (h)) * HTB)
#define PG8_SB(b, h) ((4 + (b) * 2 + (h)) * HTB)
#define PG8_STAGE(bufoff, gbase, voff) do { _Pragma("unroll") for (int _i = 0; _i < 2; ++_i) \
        __builtin_amdgcn_global_load_lds((const unsigned*)((const char*)(gbase) + (voff)[_i]), (LAS unsigned*)(lds + (bufoff) + ldsw + _i * 8192), 16, 0, 0); } while (0)
#define PG8_LDA(dst, b, h) do { _Pragma("unroll") for (int m = 0; m < 4; ++m) _Pragma("unroll") for (int k = 0; k < 2; ++k) dst[m][k] = *(const LAS bf16x8*)(lds + PG8_SA(b, h) + aoff + m * 2048 + k * 1024); } while (0)
#define PG8_LDB(dst, b, h) do { _Pragma("unroll") for (int n = 0; n < 2; ++n) _Pragma("unroll") for (int k = 0; k < 2; ++k) dst[n][k] = *(const LAS bf16x8*)(lds + PG8_SB(b, h) + boff + n * 2048 + k * 1024); } while (0)
#define PG8_MMA(ai, bj, At, Bt) do { __builtin_amdgcn_s_setprio(1); _Pragma("unroll") for (int m = 0; m < 4; ++m) _Pragma("unroll") for (int n = 0; n < 2; ++n) _Pragma("unroll") for (int k = 0; k < 2; ++k) \
        acc[ai][bj][m][n] = __builtin_amdgcn_mfma_f32_16x16x32_bf16(Bt[n][k], At[m][k], acc[ai][bj][m][n], 0, 0, 0); __builtin_amdgcn_s_setprio(0); } while (0)
#define PG8_WAIT_V(n) asm volatile("s_waitcnt vmcnt(" #n ")" ::: "memory")
#define PG8_WAIT_L(n) asm volatile("s_waitcnt lgkmcnt(" #n ")" ::: "memory")
#define PG8_BAR __builtin_amdgcn_s_barrier()
#define PG8_SCHED __builtin_amdgcn_sched_barrier(0)
    Unit cur, nxt; int ui = 0;
    if (!S.next(0, cur)) return;
    f32x4 acc[2][2][4][2];
#pragma unroll
    for (int a = 0; a < 2; ++a)
#pragma unroll
        for (int b = 0; b < 2; ++b)
#pragma unroll
            for (int m = 0; m < 4; ++m)
#pragma unroll
                for (int n = 0; n < 2; ++n) acc[a][b][m][n] = (f32x4){0.f, 0.f, 0.f, 0.f};
    bf16x8 At[4][2], B0[2][2], B1[2][2];
    const char* cA = S.aptr(cur); const char* cB = S.bptr(cur);
#define PG8_SETV(v, u) do { _Pragma("unroll") for (int h_ = 0; h_ < 2; ++h_) _Pragma("unroll") for (int i_ = 0; i_ < 2; ++i_) { \
        if constexpr (GATHER) { const int* mp_ = S.rowmap(u); (v)[h_][i_] = (unsigned)mp_[h_ * HALF + stR[i_]] * (unsigned)(g.lda * 2) + (unsigned)(stC[i_] * 2); } \
        else (v)[h_][i_] = (unsigned)((h_ * HALF + stR[i_]) * g.lda + stC[i_]) * 2u; } } while (0)
    PG8_SETV(cvA, cur);
    if constexpr (SP2) {
        PG8_STAGE(PG8_SB(0, 0), cB, voffB); PG8_STAGE(PG8_SB(0, 1), cB + hstepB, voffB); PG8_STAGE(PG8_SA(0, 0), cA, cvA[0]); PG8_STAGE(PG8_SA(0, 1), cA, cvA[1]);
        if (wr == 1) PG8_BAR;
        PG8_WAIT_V(2); PG8_BAR;
        PG8_STAGE(PG8_SB(1, 0), cB + kstep, voffB); PG8_STAGE(PG8_SA(1, 0), cA + kstep, cvA[0]); PG8_STAGE(PG8_SB(1, 1), cB + hstepB + kstep, voffB);
        PG8_WAIT_V(6); PG8_BAR;
    } else {
        PG8_STAGE(PG8_SB(0, 0), cB, voffB); PG8_STAGE(PG8_SA(0, 0), cA, cvA[0]); PG8_STAGE(PG8_SB(0, 1), cB + hstepB, voffB); PG8_STAGE(PG8_SA(0, 1), cA, cvA[1]);
        if (wr == 1) PG8_BAR;
        PG8_WAIT_V(4); PG8_BAR;
        PG8_STAGE(PG8_SB(1, 0), cB + kstep, voffB); PG8_STAGE(PG8_SA(1, 0), cA + kstep, cvA[0]); PG8_STAGE(PG8_SB(1, 1), cB + hstepB + kstep, voffB);
        PG8_WAIT_V(6); PG8_BAR;
    }
    for (;;) {
        const bool has_next = S.next(ui + 1, nxt);
        const char* nA = has_next ? S.aptr(nxt) : cA; const char* nB = has_next ? S.bptr(nxt) : cB;
        if constexpr (GATHER) { if (has_next) PG8_SETV(nvA, nxt); else {
#pragma unroll
            for (int h_ = 0; h_ < 2; ++h_) { nvA[h_][0] = cvA[h_][0]; nvA[h_][1] = cvA[h_][1]; } } }
        for (int t = 0; t < nt; t += 2) {
            const bool last = (t == nt - 2);
            const char* a1 = cA + (size_t)(t + 1) * kstep;
            const char* a2 = last ? nA : cA + (size_t)(t + 2) * kstep; const char* b2 = last ? nB : cB + (size_t)(t + 2) * kstep;
            const char* a3 = a2 + kstep; const char* b3 = b2 + kstep;
            unsigned va0[2], va1[2];
            if constexpr (GATHER) { va0[0] = last ? nvA[0][0] : cvA[0][0]; va0[1] = last ? nvA[0][1] : cvA[0][1]; va1[0] = last ? nvA[1][0] : cvA[1][0]; va1[1] = last ? nvA[1][1] : cvA[1][1]; }
            else { va0[0] = cvA[0][0]; va0[1] = cvA[0][1]; va1[0] = cvA[1][0]; va1[1] = cvA[1][1]; }
            if constexpr (SP2) {
            PG8_LDB(B0, 0, 0); PG8_LDB(B1, 0, 1); PG8_SCHED; PG8_LDA(At, 0, 0); PG8_STAGE(PG8_SA(1, 1), a1, cvA[1]);
            PG8_WAIT_V(8); PG8_WAIT_L(0); PG8_BAR; PG8_MMA(0, 0, At, B0); PG8_MMA(0, 1, At, B1); PG8_BAR; PG8_SCHED;
            PG8_LDA(At, 0, 1); PG8_STAGE(PG8_SB(0, 0), b2, voffB); PG8_STAGE(PG8_SB(0, 1), b2 + hstepB, voffB); PG8_STAGE(PG8_SA(0, 0), a2, va0);
            PG8_WAIT_V(8); PG8_WAIT_L(0); PG8_BAR; PG8_MMA(1, 0, At, B0); PG8_MMA(1, 1, At, B1); PG8_BAR; PG8_SCHED;
            PG8_LDB(B0, 1, 0); PG8_LDB(B1, 1, 1); PG8_SCHED; PG8_LDA(At, 1, 0); PG8_STAGE(PG8_SA(0, 1), a2, va1);
            PG8_WAIT_V(8); PG8_WAIT_L(0); PG8_BAR; PG8_MMA(0, 0, At, B0); PG8_MMA(0, 1, At, B1); PG8_BAR; PG8_SCHED;
            PG8_LDA(At, 1, 1); PG8_STAGE(PG8_SB(1, 0), b3, voffB); PG8_STAGE(PG8_SB(1, 1), b3 + hstepB, voffB); PG8_STAGE(PG8_SA(1, 0), a3, va0);
            PG8_WAIT_V(8); PG8_WAIT_L(0); PG8_BAR; PG8_MMA(1, 0, At, B0); PG8_MMA(1, 1, At, B1); PG8_BAR; PG8_SCHED;
            } else {
            PG8_LDB(B0, 0, 0); PG8_SCHED; PG8_LDA(At, 0, 0); PG8_STAGE(PG8_SA(1, 1), a1, cvA[1]);
            PG8_WAIT_L(8); PG8_BAR; PG8_WAIT_L(0); PG8_MMA(0, 0, At, B0); PG8_BAR; PG8_SCHED;
            PG8_LDB(B1, 0, 1); PG8_STAGE(PG8_SB(0, 0), b2, voffB);
            PG8_BAR; PG8_WAIT_L(0); PG8_MMA(0, 1, At, B1); PG8_BAR;
            PG8_LDA(At, 0, 1); PG8_STAGE(PG8_SA(0, 0), a2, va0);
            PG8_BAR; PG8_WAIT_L(0); PG8_MMA(1, 0, At, B0); PG8_BAR; PG8_SCHED;
            PG8_STAGE(PG8_SB(0, 1), b2 + hstepB, voffB);
            PG8_WAIT_V(6); PG8_BAR; PG8_MMA(1, 1, At, B1); PG8_BAR;
            PG8_LDB(B0, 1, 0); PG8_SCHED; PG8_LDA(At, 1, 0); PG8_STAGE(PG8_SA(0, 1), a2, va1);
            PG8_WAIT_L(8); PG8_BAR; PG8_WAIT_L(0); PG8_MMA(0, 0, At, B0); PG8_BAR; PG8_SCHED;
            PG8_LDB(B1, 1, 1); PG8_STAGE(PG8_SB(1, 0), b3, voffB);
            PG8_BAR; PG8_WAIT_L(0); PG8_MMA(0, 1, At, B1); PG8_BAR;
            PG8_LDA(At, 1, 1); PG8_STAGE(PG8_SA(1, 0), a3, va0);
            PG8_BAR; PG8_WAIT_L(0); PG8_MMA(1, 0, At, B0); PG8_BAR; PG8_SCHED;
            PG8_STAGE(PG8_SB(1, 1), b3 + hstepB, voffB);
            PG8_WAIT_V(6); PG8_BAR; PG8_MMA(1, 1, At, B1); PG8_BAR;
            }
        }
        if constexpr (ALIGN_EPI) { if (wr == 0) PG8_BAR; }
        E(acc, cur, wr, wc, fr, fq);
        if (!has_next) break;
#pragma unroll
        for (int a = 0; a < 2; ++a)
#pragma unroll
            for (int b = 0; b < 2; ++b)
#pragma unroll
                for (int m = 0; m < 4; ++m)
#pragma unroll
                    for (int n = 0; n < 2; ++n) acc[a][b][m][n] = (f32x4){0.f, 0.f, 0.f, 0.f};
        cur = nxt; cA = nA; cB = nB; ++ui;
        if constexpr (GATHER) {
#pragma unroll
            for (int h_ = 0; h_ < 2; ++h_) { cvA[h_][0] = nvA[h_][0]; cvA[h_][1] = nvA[h_][1]; } }
        if constexpr (ALIGN_EPI) { if (wr == 1) PG8_BAR; }
    }
    PG8_WAIT_V(0);
    if constexpr (!ALIGN_EPI) { if (wr == 0) PG8_BAR; }
    PG8_BAR;
#undef PG8_SETV
#undef PG8_SA
#undef PG8_SB
#undef PG8_STAGE
#undef PG8_LDA
#undef PG8_LDB
#undef PG8_MMA
#undef PG8_WAIT_V
#undef PG8_WAIT_L
#undef PG8_BAR
#undef PG8_SCHED
}

struct RectSched {
    const char* A; const char* Bt; size_t tsA, tsB; int nM, nN, nwg, G, c;
    __device__ __forceinline__ bool next(int i, Unit& u) const { const long L = (long)i * G + c; if (L >= nwg) return false; tile_in_rect(xcd_remap((int)L, nwg), nM, nN, u.pm, u.pn); u.z = 0; return true; }
    __device__ __forceinline__ const char* aptr(const Unit& u) const { return A + (size_t)u.pm * tsA; }
    __device__ __forceinline__ const char* bptr(const Unit& u) const { return Bt + (size_t)u.pn * tsB; }
};
struct TwoRectSched {
    const char* A0; const char* B0; const char* A1; const char* B1; size_t tsA, tsB; int nM0, nN0, nM1, nN1, pmoff1, pnoff1, G, c;
    __device__ __forceinline__ bool next(int i, Unit& u) const { const long L = (long)i * G + c; const int n0 = nM0 * nN0, n1 = nM1 * nN1; if (L >= n0 + n1) return false;
        if (L < n0) { tile_in_rect(xcd_remap((int)L, n0), nM0, nN0, u.pm, u.pn); u.z = 0; }
        else { tile_in_rect(xcd_remap((int)L - n0, n1), nM1, nN1, u.pm, u.pn); u.pm += pmoff1; u.pn += pnoff1; u.z = 1; }
        return true; }
    __device__ __forceinline__ const char* aptr(const Unit& u) const { return u.z ? A1 + (size_t)(u.pm - pmoff1) * tsA : A0 + (size_t)u.pm * tsA; }
    __device__ __forceinline__ const char* bptr(const Unit& u) const { return u.z ? B1 + (size_t)(u.pn - pnoff1) * tsB : B0 + (size_t)u.pn * tsB; }
};
struct GroupSched {
    const char* A; const char* Bt; size_t tsA, tsB; int tM, tN, nE, G, c; const int* map;
    bool rev = false;
    __device__ __forceinline__ const int* rowmap(const Unit& u) const { return map + u.pm * 256; }
    __device__ __forceinline__ bool next(int i, Unit& u) const { const int per = tM * tN, nwg = per * nE; const long L = (long)i * G + c; if (L >= nwg) return false;
        int w = xcd_remap((int)L, nwg); if (rev && (nwg % NXCD) == 0) { const int q = nwg / NXCD; w = (w / q) * q + (q - 1 - (w % q)); }
        const int e = w / per; int pm, pn; tile_in_rect(w % per, tM, tN, pm, pn); u.pm = e * tM + pm; u.pn = e * tN + pn; u.z = e; return true; }
    __device__ __forceinline__ const char* aptr(const Unit& u) const { return map ? A : A + (size_t)u.pm * tsA; }
    __device__ __forceinline__ const char* bptr(const Unit& u) const { return Bt + (size_t)u.pn * tsB; }
};
}
#define XB_TMO      128
#define XB_XCNT(j)  (256  + 64 * (j))
#define XB_XSUB(j)  (1280 + 64 * (j))
#define XB_XGEN(j)  (2304 + 64 * (j))
#define XB_TOP      3328
#define XB_TOPGEN   3392
#define XCD_BAR_WORDS 3456
#define XB_SPIN_CAP (1u << 20)

__device__ __forceinline__ unsigned xb_ld(unsigned* p)              { return __hip_atomic_load(p, __ATOMIC_RELAXED, __HIP_MEMORY_SCOPE_AGENT); }
__device__ __forceinline__ unsigned xb_add(unsigned* p, unsigned v) { return __hip_atomic_fetch_add(p, v, __ATOMIC_RELAXED, __HIP_MEMORY_SCOPE_AGENT); }
__device__ __forceinline__ unsigned xb_xcc_id() { return (unsigned)__builtin_amdgcn_s_getreg((3 << 11) | 20) & 0xFu; }
#ifndef XB_SLEEP
#define XB_SLEEP 0
#endif
#define XB_SPIN(cond, bar) do { unsigned _sp = 0; while (cond) { if (XB_SLEEP) __builtin_amdgcn_s_sleep(1); \
    if ((++_sp & 255u) == 0u) { if (xb_ld(&(bar)[XB_TMO])) break; if (_sp > XB_SPIN_CAP) { atomicAdd(&(bar)[XB_TMO], 1u); break; } } } } while (0)

struct XcdBarrier { unsigned* bar; unsigned x; volatile LAS unsigned* st; };

__device__ __forceinline__ XcdBarrier xcd_barrier_post(unsigned* bar, volatile LAS unsigned* st) {
    XcdBarrier b; b.bar = bar; b.x = xb_xcc_id(); b.st = st;
    if (threadIdx.x == 0) (void)xb_add(&bar[XB_XCNT(b.x)], 1u);
    return b;
}
__device__ __forceinline__ void xcd_barrier_complete(unsigned* bar, unsigned x, unsigned& nloc, unsigned& nx) {
    const unsigned G = gridDim.x * gridDim.y * gridDim.z;
    unsigned sum, cnt, mine, sp = 0u;
    for (;;) {
        sum = 0u; cnt = 0u; mine = 0u;
#pragma unroll
        for (unsigned j = 0; j < 16; ++j) { const unsigned c = xb_ld(&bar[XB_XCNT(j)]); sum += c; cnt += (c > 0u) ? 1u : 0u; mine = (j == x) ? c : mine; }
        if (sum == G) break;
        __builtin_amdgcn_s_sleep(1);
        if ((++sp & 255u) == 0u) { if (xb_ld(&bar[XB_TMO])) break; if (sp > XB_SPIN_CAP) { atomicAdd(&bar[XB_TMO], 1u); break; } }
    }
    nloc = mine > 0u ? mine : 1u; nx = cnt > 0u ? cnt : 1u;
}
__device__ __forceinline__ void xcd_barrier(const XcdBarrier& b) {
    asm volatile("s_waitcnt vmcnt(0)" ::: "memory");
    __syncthreads();
    if (threadIdx.x == 0) {
        unsigned* bar = b.bar;
        __builtin_amdgcn_s_waitcnt(0);
        unsigned nloc = b.st[0], nx = b.st[1];
        if (nloc == 0u) { xcd_barrier_complete(bar, b.x, nloc, nx); b.st[0] = nloc; b.st[1] = nx; }
        const unsigned old = xb_add(&bar[XB_XSUB(b.x)], 1u);
        const unsigned gen = old / nloc;
        if (old + 1u == (gen + 1u) * nloc) {
            __builtin_amdgcn_fence(__ATOMIC_RELEASE, "agent");
            asm volatile("s_waitcnt vmcnt(0)" ::: "memory");
            const unsigned og = xb_add(&bar[XB_TOP], 1u);
            const unsigned tg = og / nx;
            if (og + 1u == (tg + 1u) * nx) xb_add(&bar[XB_TOPGEN], 1u);
            else XB_SPIN(xb_ld(&bar[XB_TOPGEN]) == tg, bar);
            __builtin_amdgcn_fence(__ATOMIC_ACQUIRE, "agent");
            xb_add(&bar[XB_XGEN(b.x)], 1u);
            asm volatile("s_waitcnt vmcnt(0)" ::: "memory");
        } else {
            XB_SPIN(xb_ld(&bar[XB_XGEN(b.x)]) == gen, bar);
            __builtin_amdgcn_fence(__ATOMIC_ACQUIRE, "agent");
            asm volatile("s_waitcnt vmcnt(0)" ::: "memory");
        }
    }
    __syncthreads();
}
constexpr size_t al256(size_t x) { return (x + 255) / 256 * 256; }
constexpr size_t WS_CTL = 0, CTL_BYTES = 1u << 20;
constexpr size_t WS_WEV = WS_CTL + CTL_BYTES;
constexpr size_t WS_WOD = WS_WEV + (size_t)EVN * D * 2;
constexpr size_t WS_WO  = WS_WOD + (size_t)ODN * D * 2;
constexpr size_t WS_WQ  = WS_WO + (size_t)2 * D * D * 2;
constexpr size_t WS_WKV = WS_WQ + (size_t)1536 * 512 * 2;
constexpr size_t WS_WL  = WS_WKV + (size_t)2048 * 512 * 2;
constexpr size_t WS_WGU = WS_WL + (size_t)32 * 128 * 128 * 2;
constexpr size_t WS_WDN = WS_WGU + (size_t)2 * NE * GUN * D * 2;
constexpr size_t WS_MODP = WS_WDN + (size_t)2 * NE * D * FF * 2;
constexpr size_t WS_MOD = WS_MODP + (size_t)2 * MODS * 5 * 12288 * 4;
constexpr size_t WS_ROPE = WS_MOD + (size_t)2 * 5 * 12288 * 4;
constexpr size_t WS_LB = WS_ROPE + (size_t)4096 * 64 * 4;
constexpr size_t WS_XA = al256(WS_LB + 2 * 1024 * 4);
constexpr size_t WS_X1B = WS_XA + (size_t)R * D * 2;
constexpr size_t WS_H = WS_XA + (size_t)R * D * 4;
constexpr size_t WS_Y = WS_H + (size_t)(R + 1) * D * 2;
constexpr size_t WS_BIG = WS_Y + (size_t)R * D * 2;
constexpr size_t WS_U0 = WS_BIG;
constexpr size_t WS_OD = WS_U0 + (size_t)R * EVN * 2;
constexpr size_t WS_HD = WS_OD + (size_t)2 * R * 1024 * 2;
constexpr size_t WS_LA = WS_HD + (size_t)2 * R * 1024 * 2;
constexpr size_t WS_BB = WS_LA + (size_t)2 * R * 1024 * 2;
constexpr size_t WS_BIG_END0 = WS_BB + (size_t)2 * R * 1024 * 2;
constexpr size_t WS_DELTA = WS_BIG + ((size_t)300 << 20);
static_assert(WS_DELTA + (size_t)R * D * 2 <= WS_BIG_END0, "delta");
constexpr int MROWS0 = 2304, MROWS1 = 2048;
constexpr size_t WS_HID = WS_BIG;
constexpr size_t WS_YE = WS_HID + (size_t)NE * MROWS0 * FF * 2;
constexpr size_t WS_AFFL = WS_YE + (size_t)NE * MROWS0 * D * 2;
constexpr size_t WS_AFFC = WS_AFFL + (size_t)NB * NE * TL * 4;
constexpr size_t WS_ROWMAP = WS_AFFC + (size_t)NB * NE * TC * 4;
constexpr size_t WS_IDXC = WS_ROWMAP + (size_t)NE * MROWS0 * 4;
constexpr size_t WS_GATL = WS_IDXC + (size_t)NB * NE * CAPC * 4;
constexpr size_t WS_GATC = WS_GATL + (size_t)NB * NE * CAPL * 4;
constexpr size_t WS_POS = WS_GATC + (size_t)NB * NE * CAPC * 4;
constexpr size_t WS_GROW = WS_POS + (size_t)R * NE * 4;
constexpr size_t WS_BIG_ENDM = WS_GROW + (size_t)NE * MROWS0 * 4;
static_assert(WS_BIG_ENDM <= WS_DELTA, "delta vs MoE view");
constexpr size_t WS_U1 = WS_BIG;
constexpr size_t WS_Q = WS_U1 + (size_t)R * ODN * 2;
constexpr size_t WS_KF = WS_Q + (size_t)NB * 8 * TL * 192 * 2;
constexpr size_t WS_VF = WS_KF + (size_t)NB * 8 * KSEQ * 192 * 2;
constexpr size_t WS_XBC = WS_VF + (size_t)NB * 8 * KSEQ * 128 * 2;
constexpr size_t WS_DT = WS_XBC + (size_t)R * 1536 * 4;
constexpr size_t WS_RINV = WS_DT + (size_t)R * 32 * 4;
constexpr size_t WS_YS = WS_RINV + (size_t)2 * R * 4;
constexpr size_t WS_BIG_END1 = WS_YS + (size_t)2 * RL * 1024 * 2;
constexpr size_t cmax(size_t a, size_t b) { return a > b ? a : b; }
constexpr size_t WS_END = al256(cmax(WS_BIG_END0, cmax(WS_BIG_ENDM, WS_BIG_END1)));

constexpr int LDS_SCRATCH = 131072;
constexpr int LDS_MISC = LDS_SCRATCH;
constexpr int LDS_XTRA = LDS_MISC + 256;
constexpr int LDS_BYTES = 151552;

struct Params { const float* in[35]; float* out; unsigned char* ws; int ph_lo, ph_hi; };
enum In { I_X = 0, I_C, I_CTX, I_CCTX, I_WMOD, I_BMOD, I_NMIX, I_NFFN, I_WOUT, I_EVW, I_HGLB, I_HGON, I_LCW, I_LCB, I_LWA, I_LBA, I_LWX, I_LBX, I_LLAM,
          I_ODW, I_QN, I_WQU, I_KVN, I_WKVU, I_SCW, I_SCB, I_SDTB, I_SALOG, I_SD, I_SON, I_ROUT, I_WG, I_WU, I_WD, I_FN };

struct Frame {
    LAS unsigned char* lds;
    const float* const* in; float* out; unsigned char* ws;
    int tid, lane, wave, bid, G;
    template <class T> __device__ __forceinline__ T* w(size_t off) const { return (T*)(ws + off); }
    __device__ __forceinline__ int gw() const { return bid * NWAVES + wave; }
    __device__ __forceinline__ int ngw() const { return G * NWAVES; }
};
__device__ __forceinline__ int xcd_chunk(const Frame& F) { return (F.G & 7) == 0 ? (F.bid & 7) * (F.G >> 3) + (F.bid >> 3) : F.bid; }
__device__ __forceinline__ int row_bsel(int r) { return r < RL ? (r >> 12) : 4; }
__device__ __forceinline__ const float* mod_ptr(const Frame& F, int l, int bsel, int chunk) { return F.w<const float>(WS_MOD) + ((size_t)(l * 5 + bsel) * 6 + chunk) * 2048; }
#ifndef PRO_DUP_MODP
#define PRO_DUP_MODP 1
#endif
template <bool SC>
__device__ __forceinline__ void tr_item(const float* W, int ldsrc, int srccol, const float* kscale, bf16_t* WT, int K, int k0, int n0, LAS float* scr, int lane) {
    float v[32]; const int sc_ = srccol >= 0 ? srccol : 0; const float* Wp = W + (size_t)(k0 + (lane >> 5)) * ldsrc + sc_;
#pragma unroll
    for (int i = 0; i < 32; ++i) v[i] = Wp[(size_t)(2 * i) * ldsrc];
    if constexpr (SC) { float ks[32]; const float* kp = kscale + k0 + (lane >> 5);
#pragma unroll
        for (int i = 0; i < 32; ++i) ks[i] = kp[2 * i];
#pragma unroll
        for (int i = 0; i < 32; ++i) v[i] *= ks[i]; }
    const float keep = srccol >= 0 ? 1.0f : 0.0f;
#pragma unroll
    for (int i = 0; i < 32; ++i) scr[(2 * i + (lane >> 5)) * 33 + (lane & 31)] = v[i] * keep;
    LDS_WAIT(); asm volatile("" ::: "memory");
    const int c = lane & 7;
#pragma unroll
    for (int j = 0; j < 4; ++j) { const int n = (lane >> 3) + 8 * j; const LAS float* s = scr + (8 * c) * 33 + n;
        u32x4 o; o.x = pk2(s[0 * 33], s[1 * 33]); o.y = pk2(s[2 * 33], s[3 * 33]); o.z = pk2(s[4 * 33], s[5 * 33]); o.w = pk2(s[6 * 33], s[7 * 33]);
        *(u32x4*)(WT + (size_t)(n0 + n) * K + k0 + 8 * c) = o; }
    LDS_WAIT(); asm volatile("" ::: "memory");
}
__device__ __forceinline__ int od_map(int n) {
    if (n < 2048) return n;
    if (n < 3584) return n + 64;
    if (n < 3648) { const int j = n - 3584; return 2048 + (j >> 1) + 32 * (j & 1); }
    if (n < 3680) return n;
    return -1;
}
__device__ __forceinline__ int qup_map(int n) { const int h = n / 192, dd = n % 192; if (dd < 128) return n; const int j = dd - 128; return h * 192 + 128 + (j >> 1) + 32 * (j & 1); }

constexpr int IT_GU = NE * 32 * 88, IT_DN = NE * 22 * 64, IT_MOE = IT_GU + IT_DN;
struct MoeItem { const float* src; bf16_t* dst; int ldsrc, K; };
__device__ __forceinline__ MoeItem moe_item_desc(const Frame& F, int l, int it) {
    MoeItem m;
    if (it < IT_GU) { const int e = it / (32 * 88), r = it % (32 * 88), kb = r / 88, nb = r % 88, n0 = nb * 32, j = n0 >> 8, rr = n0 & 255;
        m.src = (rr < 128 ? F.in[I_WG] : F.in[I_WU]) + (size_t)(l * NE + e) * D * FF + (size_t)(kb * 64 + (F.lane >> 5)) * FF + 128 * j + (rr & 127) + (F.lane & 31); m.ldsrc = FF; m.K = D;
        m.dst = F.w<bf16_t>(WS_WGU) + ((size_t)(l * NE + e) * GUN + n0) * D + kb * 64;
    } else { it -= IT_GU; const int e = it / (22 * 64), r = it % (22 * 64), kb = r / 64, nb = r % 64;
        m.src = F.in[I_WD] + (size_t)(l * NE + e) * FF * D + (size_t)(kb * 64 + (F.lane >> 5)) * D + nb * 32 + (F.lane & 31); m.ldsrc = D; m.K = FF;
        m.dst = F.w<bf16_t>(WS_WDN) + ((size_t)(l * NE + e) * D + nb * 32) * FF + kb * 64;
    }
    return m;
}
__device__ __forceinline__ void moe_item_load(const MoeItem& m, float (&v)[32]) {
#pragma unroll
    for (int i = 0; i < 32; ++i) v[i] = __builtin_nontemporal_load(m.src + (size_t)(2 * i) * m.ldsrc);
}
__device__ __forceinline__ void moe_item_finish(const MoeItem& m, const float (&v)[32], LAS float* scr, int lane) {
#pragma unroll
    for (int i = 0; i < 32; ++i) scr[(2 * i + (lane >> 5)) * 33 + (lane & 31)] = v[i];
    LDS_WAIT(); asm volatile("" ::: "memory");
    const int c = lane & 7;
#pragma unroll
    for (int j = 0; j < 4; ++j) { const int n = (lane >> 3) + 8 * j; const LAS float* s = scr + (8 * c) * 33 + n;
        u32x4 o; o.x = pk2c(s[0 * 33], s[1 * 33]); o.y = pk2c(s[2 * 33], s[3 * 33]); o.z = pk2c(s[4 * 33], s[5 * 33]); o.w = pk2c(s[6 * 33], s[7 * 33]);
        __builtin_nontemporal_store(o, (u32x4*)(m.dst + (size_t)n * m.K + 8 * c)); }
    LDS_WAIT(); asm volatile("" ::: "memory");
}
#ifndef HC_PLLO
#define HC_PLLO 66048
#endif
constexpr int PL_LO = HC_PLLO;
static_assert(PL_LO <= IT_MOE, "plan");
__device__ __forceinline__ void moe_convert_range(const Frame& F, int l, int lo, int hi, int first, int stride) {
    LAS float* scr = (LAS float*)(F.lds + F.wave * 8448);
    int it = lo + first; if (it >= hi) return;
    MoeItem mA = moe_item_desc(F, l, it), mB = mA; float vA[32], vB[32];
    moe_item_load(mA, vA);
#pragma unroll 1
    for (;;) {
        it += stride; const bool hb = it < hi;
        if (hb) { mB = moe_item_desc(F, l, it); moe_item_load(mB, vB); }
        moe_item_finish(mA, vA, scr, F.lane);
        if (!hb) break;
        it += stride; const bool ha = it < hi;
        if (ha) { mA = moe_item_desc(F, l, it); moe_item_load(mA, vA); }
        moe_item_finish(mB, vB, scr, F.lane);
        if (!ha) break;
    }
}

__device__ __forceinline__ void phase_prologue(const Frame& F) {
    LAS float* scr = (LAS float*)(F.lds + F.wave * 8448);
    const int gw = F.gw(), ngw = F.ngw();
    constexpr int IT_EV = 32 * (EVN / 32), IT_OD = 32 * (ODN / 32), IT_WO = 2 * 32 * 64, IT_Q = 8 * 48, IT_KV = 8 * 64, IT_L = 32 * 8;
    constexpr int IT_MODP = 2 * MODS * 48, IT_ROPE = 2048, IT_LB = 32;
    constexpr int NIT = IT_EV + IT_OD + IT_WO + IT_Q + IT_KV + IT_L + IT_MODP + IT_ROPE + IT_LB;
    for (int it0 = gw; it0 < NIT; it0 += ngw) {
        int it = it0;
        if (it < IT_MODP) {
            const int l = it / (MODS * 48), s = (it / 48) % MODS, cb = it % 48, n = cb * 256 + 4 * F.lane, k0 = s * 64;
            float scv[5];
#pragma unroll
            for (int j = 0; j < 5; ++j) scv[j] = siluf_(j < 4 ? F.in[I_C][j * 2048 + k0 + F.lane] : F.in[I_CCTX][k0 + F.lane]);
            const float* W = F.in[I_WMOD] + (size_t)l * D * 12288 + (size_t)k0 * 12288 + n;
            f32x4 acc5[5];
#pragma unroll 1
            for (int rr_ = 0; rr_ < PRO_DUP_MODP; ++rr_) {
#pragma unroll
            for (int j = 0; j < 5; ++j) acc5[j] = (f32x4){0.f, 0.f, 0.f, 0.f};
#pragma unroll 16
            for (int k = 0; k < 64; ++k) { const f32x4 w = *(const f32x4*)(W + (size_t)k * 12288);
#pragma unroll
                for (int j = 0; j < 5; ++j) { const float sc = __int_as_float(__builtin_amdgcn_readlane(__float_as_int(scv[j]), k)); acc5[j] += w * sc; } }
            asm volatile("" ::: "memory"); }
            float* o = F.w<float>(WS_MODP) + ((size_t)(l * MODS + s) * 5) * 12288 + n;
#pragma unroll
            for (int j = 0; j < 5; ++j) *(f32x4*)(o + (size_t)j * 12288) = acc5[j];
            continue; }
        it -= IT_MODP;
        if (it < IT_EV) { const int nblk = EVN / 32, kb = it / nblk, nb = it % nblk; tr_item<false>(F.in[I_EVW], EVN, nb * 32 + (F.lane & 31), nullptr, F.w<bf16_t>(WS_WEV), D, kb * 64, nb * 32, scr, F.lane); continue; }
        it -= IT_EV;
        if (it < IT_OD) { const int nblk = ODN / 32, kb = it / nblk, nb = it % nblk; tr_item<false>(F.in[I_ODW], ODSRC, od_map(nb * 32 + (F.lane & 31)), nullptr, F.w<bf16_t>(WS_WOD), D, kb * 64, nb * 32, scr, F.lane); continue; }
        it -= IT_OD;
        if (it < IT_WO) { const int l = it / (32 * 64), r = it % (32 * 64), kb = r / 64, nb = r % 64; tr_item<false>(F.in[I_WOUT] + (size_t)l * D * D, D, nb * 32 + (F.lane & 31), nullptr, F.w<bf16_t>(WS_WO) + (size_t)l * D * D, D, kb * 64, nb * 32, scr, F.lane); continue; }
        it -= IT_WO;
        if (it < IT_Q) { const int kb = it / 48, nb = it % 48; tr_item<true>(F.in[I_WQU], 1536, qup_map(nb * 32 + (F.lane & 31)), F.in[I_QN], F.w<bf16_t>(WS_WQ), 512, kb * 64, nb * 32, scr, F.lane); continue; }
        it -= IT_Q;
        if (it < IT_KV) { const int kb = it / 64, nb = it % 64; tr_item<true>(F.in[I_WKVU], 2048, nb * 32 + (F.lane & 31), F.in[I_KVN], F.w<bf16_t>(WS_WKV), 512, kb * 64, nb * 32, scr, F.lane); continue; }
        it -= IT_KV;
        if (it < IT_L) { const int mat = it / 8, r = it % 8, kb = r / 4, nb = r % 4, d = mat >> 4, ax = (mat >> 3) & 1, hb = mat & 7;
            const float* src = (ax ? F.in[I_LWX] : F.in[I_LWA]) + (size_t)(d * 8 + hb) * 128 * 128;
            tr_item<false>(src, 128, nb * 32 + (F.lane & 31), nullptr, F.w<bf16_t>(WS_WL) + (size_t)mat * 128 * 128, 128, kb * 64, nb * 32, scr, F.lane); continue; }
        it -= IT_L;
        if (it < IT_ROPE) {
            const int idx = it * 64 + F.lane, t = idx >> 5, i = idx & 31;
            const float inv = exp2f(-(float)(i & 15) * 0.8304820237218406f);
            const float pos = (i < 16) ? (float)(t >> 6) : (float)(t & 63);
            float rev = (pos * inv) * 0.15915494309189535f; rev -= floorf(rev);
            F.w<f32x2>(WS_ROPE)[idx] = (f32x2){__builtin_amdgcn_cosf(rev), __builtin_amdgcn_sinf(rev)};
            continue; }
        it -= IT_ROPE;
        { const int idx = it * 64 + F.lane, d = idx >> 10, k = idx & 1023;
          const float a0 = F.in[I_HGLB][d * 2048 + k], a1 = F.in[I_HGLB][d * 2048 + 1024 + k];
          F.w<float>(WS_LB)[idx] = 1.0f / (1.0f + expf(a1 - a0)); }
    }
    moe_convert_range(F, 0, F.G == 256 ? PL_LO : 0, IT_MOE, gw, ngw);
}

template <class FSc, class FSh>
__device__ __forceinline__ void norm_mod_row(const float (&v)[32], const float* nw, FSc sc, FSh sh, bf16_t* orow, int lane) {
    float ss = 0.f;
#pragma unroll
    for (int i = 0; i < 32; ++i) ss += v[i] * v[i];
    const float rinv = rsqrtf(wave_sum(ss) * (1.0f / D) + EPS);
    float o[32];
#pragma unroll
    for (int j = 0; j < 4; ++j)
#pragma unroll
        for (int q = 0; q < 8; ++q) { const int d = (j * 64 + lane) * 8 + q; o[8 * j + q] = v[8 * j + q] * rinv * nw[d] * (1.0f + sc(d)) + sh(d); }
    store_row_bf16(orow, lane, o);
}
__device__ __forceinline__ const float* x_in_row(const Frame& F, int r) { return r < RL ? F.in[I_X] + (size_t)r * D : F.in[I_CTX] + (size_t)(r - RL) * D; }

__device__ __forceinline__ void phase_norm0(const Frame& F) {
    for (int i = F.bid * NTHR + F.tid; i < 2 * 5 * 12288; i += F.G * NTHR) { const int l = i / (5 * 12288), rem = i % (5 * 12288), j = rem / 12288, n = rem % 12288;
        float a = F.in[I_BMOD][l * 12288 + n]; const float* p = F.w<const float>(WS_MODP) + ((size_t)(l * MODS) * 5 + j) * 12288 + n;
#pragma unroll
        for (int s = 0; s < MODS; ++s) a += p[(size_t)s * 5 * 12288];
        F.w<float>(WS_MOD)[i] = a; }
    if (F.bid == 0) for (int i = F.tid; i < D / 2; i += NTHR) ((unsigned*)(F.w<bf16_t>(WS_H) + (size_t)R * D))[i] = 0u;
    LAS float* SH = (LAS float*)F.lds; LAS float* SCL = SH + 2048;
    const int per = (R + F.G - 1) / F.G, r0 = xcd_chunk(F) * per, r1 = (r0 + per < R) ? r0 + per : R;
    int cur = -1;
    for (int rb = r0; rb < r1; rb += NWAVES) {
        const int r = rb + F.wave;
        const int bs_first = row_bsel(rb), bs_last = row_bsel((rb + NWAVES - 1 < r1 ? rb + NWAVES - 1 : r1 - 1));
        for (int pass = 0; pass < (bs_first == bs_last ? 1 : 2); ++pass) {
            const int bs = pass == 0 ? bs_first : bs_last;
            if (bs != cur) {
                __syncthreads();
                for (int i = F.tid; i < 4096; i += NTHR) { const int n = i;
                    float a = F.in[I_BMOD][n]; const float* p = F.w<const float>(WS_MODP) + ((size_t)bs) * 12288 + n;
#pragma unroll
                    for (int s = 0; s < MODS; ++s) a += p[(size_t)s * 5 * 12288];
                    SH[i] = a; }
                __syncthreads();
                cur = bs;
            }
            if (r < r1 && row_bsel(r) == bs) {
                float v[32]; load_row_f32(x_in_row(F, r), F.lane, v);
                norm_mod_row(v, F.in[I_NMIX], [&](int d) { return SCL[d]; }, [&](int d) { return SH[d]; }, F.w<bf16_t>(WS_H) + (size_t)r * D, F.lane);
            }
        }
    }
}
typedef f32x4 AccT[2][2][4][2];
#ifndef EPI_WIDE
#define EPI_WIDE 1
#endif
constexpr int CW = EPI_WIDE ? 64 : 32, CBJ = EPI_WIDE ? 32 : 128;

struct EpiStoreBf16 {
    static constexpr bool PERM = true, WIDE = EPI_WIDE;
    bf16_t* O; int ldc;
    __device__ __forceinline__ void operator()(const AccT& acc, const pg8::Unit& u, int wr, int wc, int fr, int fq) const {
        const int row0 = u.pm * 256 + wr * 64 + fr, col0 = u.pn * 256 + wc * CW + 8 * fq;
#pragma unroll
        for (int ai = 0; ai < 2; ++ai)
#pragma unroll
            for (int m = 0; m < 4; ++m) { bf16_t* rowp = O + (size_t)(row0 + ai * 128 + m * 16) * ldc + col0;
#pragma unroll
                for (int bj = 0; bj < 2; ++bj) { const f32x4 v0 = acc[ai][bj][m][0], v1 = acc[ai][bj][m][1];
                    u32x4 w; w.x = pk2c(v0[0], v0[1]); w.y = pk2c(v0[2], v0[3]); w.z = pk2c(v1[0], v1[1]); w.w = pk2c(v1[2], v1[3]);
                    *(u32x4*)(rowp + bj * CBJ) = w; } }
    }
};
struct EpiEv {
    static constexpr bool PERM = true, WIDE = EPI_WIDE;
    bf16_t* O; const float* LB;
    __device__ __forceinline__ void operator()(const AccT& acc, const pg8::Unit& u, int wr, int wc, int fr, int fq) const {
        const int row0 = u.pm * 256 + wr * 64 + fr, col0 = u.pn * 256 + wc * CW + 8 * fq;
        const int mode = (u.pn < 4) ? 1 : ((u.pn >= 12 && u.pn < 20) ? 2 : 0);
        if (mode == 2) {
            f32x4 lbv[2][2];
#pragma unroll
            for (int bj = 0; bj < 2; ++bj) { lbv[bj][0] = *(const f32x4*)(LB + col0 - 3072 + bj * CBJ); lbv[bj][1] = *(const f32x4*)(LB + col0 - 3072 + bj * CBJ + 4); }
            asm volatile("" : "+v"(lbv[0][0]), "+v"(lbv[0][1]), "+v"(lbv[1][0]), "+v"(lbv[1][1]) :: "memory");
#pragma unroll
            for (int ai = 0; ai < 2; ++ai)
#pragma unroll
                for (int m = 0; m < 4; ++m) { bf16_t* rowp = O + (size_t)(row0 + ai * 128 + m * 16) * EVN + col0;
#pragma unroll
                    for (int bj = 0; bj < 2; ++bj) { f32x4 v0 = acc[ai][bj][m][0], v1 = acc[ai][bj][m][1];
#pragma unroll
                        for (int q = 0; q < 4; ++q) { const float l0 = lbv[bj][0][q], l1 = lbv[bj][1][q];
                            v0[q] = __builtin_amdgcn_logf(l0 + (1.0f - l0) * sigmoidf_(v0[q])); v1[q] = __builtin_amdgcn_logf(l1 + (1.0f - l1) * sigmoidf_(v1[q])); }
                        u32x4 w; w.x = pk2c(v0[0], v0[1]); w.y = pk2c(v0[2], v0[3]); w.z = pk2c(v1[0], v1[1]); w.w = pk2c(v1[2], v1[3]);
                        *(u32x4*)(rowp + bj * CBJ) = w; } }
        } else if (mode == 1) {
#pragma unroll
            for (int ai = 0; ai < 2; ++ai)
#pragma unroll
                for (int m = 0; m < 4; ++m) { bf16_t* rowp = O + (size_t)(row0 + ai * 128 + m * 16) * EVN + col0;
#pragma unroll
                    for (int bj = 0; bj < 2; ++bj) { f32x4 v0 = acc[ai][bj][m][0], v1 = acc[ai][bj][m][1];
#pragma unroll
                        for (int q = 0; q < 4; ++q) { v0[q] = siluf_(v0[q]); v1[q] = siluf_(v1[q]); }
                        u32x4 w; w.x = pk2c(v0[0], v0[1]); w.y = pk2c(v0[2], v0[3]); w.z = pk2c(v1[0], v1[1]); w.w = pk2c(v1[2], v1[3]);
                        *(u32x4*)(rowp + bj * CBJ) = w; } }
        } else {
#pragma unroll
            for (int ai = 0; ai < 2; ++ai)
#pragma unroll
                for (int m = 0; m < 4; ++m) { bf16_t* rowp = O + (size_t)(row0 + ai * 128 + m * 16) * EVN + col0;
#pragma unroll
                    for (int bj = 0; bj < 2; ++bj) { const f32x4 v0 = acc[ai][bj][m][0], v1 = acc[ai][bj][m][1];
                        u32x4 w; w.x = pk2c(v0[0], v0[1]); w.y = pk2c(v0[2], v0[3]); w.z = pk2c(v1[0], v1[1]); w.w = pk2c(v1[2], v1[3]);
                        *(u32x4*)(rowp + bj * CBJ) = w; } }
        }
    }
};
struct EpiDelta {
    static constexpr bool PERM = true, WIDE = EPI_WIDE;
    bf16_t* O; const float* mod;
    __device__ __forceinline__ void operator()(const AccT& acc, const pg8::Unit& u, int wr, int wc, int fr, int fq) const {
        const int row0 = u.pm * 256 + wr * 64 + fr, col0 = u.pn * 256 + wc * CW + 8 * fq;
        const float* g = mod + (size_t)(row_bsel(u.pm * 256) * 6 + 2) * 2048 + col0;
        f32x4 gv[2][2];
#pragma unroll
        for (int bj = 0; bj < 2; ++bj) { gv[bj][0] = *(const f32x4*)(g + bj * CBJ); gv[bj][1] = *(const f32x4*)(g + bj * CBJ + 4); }
        asm volatile("" : "+v"(gv[0][0]), "+v"(gv[0][1]), "+v"(gv[1][0]), "+v"(gv[1][1]) :: "memory");
#pragma unroll
        for (int ai = 0; ai < 2; ++ai)
#pragma unroll
            for (int m = 0; m < 4; ++m) { bf16_t* rowp = O + (size_t)(row0 + ai * 128 + m * 16) * D + col0;
#pragma unroll
                for (int bj = 0; bj < 2; ++bj) { const f32x4 v0 = acc[ai][bj][m][0] * gv[bj][0], v1 = acc[ai][bj][m][1] * gv[bj][1];
                    u32x4 w; w.x = pk2c(v0[0], v0[1]); w.y = pk2c(v0[2], v0[3]); w.z = pk2c(v1[0], v1[1]); w.w = pk2c(v1[2], v1[3]);
                    *(u32x4*)(rowp + bj * CBJ) = w; } }
    }
};
struct EpiResid {
    static constexpr bool PERM = false, WIDE = false;
    const float* xin; const float* cin; float* XA; const float* mod;
    __device__ __forceinline__ void operator()(const AccT& acc, const pg8::Unit& u, int wr, int wc, int fr, int fq) const {
        const int row0 = u.pm * 256 + wr * 64 + fr, col0 = u.pn * 256 + wc * 32 + 4 * fq;
        const int bsel = row_bsel(u.pm * 256);
        const float* g = mod + (size_t)(bsel * 6 + 2) * 2048;
        f32x4 gv[2][2];
#pragma unroll
        for (int bj = 0; bj < 2; ++bj)
#pragma unroll
            for (int n = 0; n < 2; ++n) gv[bj][n] = *(const f32x4*)(g + col0 + bj * 128 + n * 16);
#pragma unroll
        for (int ai = 0; ai < 2; ++ai)
#pragma unroll
            for (int m = 0; m < 4; ++m) { const int r = row0 + ai * 128 + m * 16;
                const float* bp = xin ? (r < RL ? xin + (size_t)r * D : cin + (size_t)(r - RL) * D) : XA + (size_t)r * D;
                float* op = XA + (size_t)r * D;
#pragma unroll
                for (int bj = 0; bj < 2; ++bj)
#pragma unroll
                    for (int n = 0; n < 2; ++n) { const int c = col0 + bj * 128 + n * 16; const f32x4 b = *(const f32x4*)(bp + c); *(f32x4*)(op + c) = b + gv[bj][n] * acc[ai][bj][m][n]; } }
    }
};
struct EpiGateUp {
    static constexpr bool PERM = true, WIDE = false;
    bf16_t* HID;
    __device__ __forceinline__ void operator()(const AccT& acc, const pg8::Unit& u, int wr, int wc, int fr, int fq) const {
        const int row0 = u.pm * 256 + wr * 64 + fr, j = u.pn % 11, col0 = j * 128 + wc * 32 + 8 * fq;
#pragma unroll
        for (int ai = 0; ai < 2; ++ai)
#pragma unroll
            for (int m = 0; m < 4; ++m) { bf16_t* rowp = HID + (size_t)(row0 + ai * 128 + m * 16) * FF + col0;
                const f32x4 g0 = acc[ai][0][m][0], g1 = acc[ai][0][m][1], u0 = acc[ai][1][m][0], u1 = acc[ai][1][m][1];
                u32x4 w; w.x = pk2c(siluf_(g0[0]) * u0[0], siluf_(g0[1]) * u0[1]); w.y = pk2c(siluf_(g0[2]) * u0[2], siluf_(g0[3]) * u0[3]);
                w.z = pk2c(siluf_(g1[0]) * u1[0], siluf_(g1[1]) * u1[1]); w.w = pk2c(siluf_(g1[2]) * u1[2], siluf_(g1[3]) * u1[3]);
                *(u32x4*)rowp = w; }
    }
};
struct EpiDown {
    static constexpr bool PERM = true, WIDE = EPI_WIDE;
    bf16_t* YE; const float* grow;
    __device__ __forceinline__ void operator()(const AccT& acc, const pg8::Unit& u, int wr, int wc, int fr, int fq) const {
        const int row0 = u.pm * 256 + wr * 64 + fr, col0 = (u.pn & 7) * 256 + wc * CW + 8 * fq;
        float gtv[2][4];
#pragma unroll
        for (int ai = 0; ai < 2; ++ai)
#pragma unroll
            for (int m = 0; m < 4; ++m) gtv[ai][m] = grow[row0 + ai * 128 + m * 16];
        asm volatile("" : "+v"(gtv[0][0]), "+v"(gtv[0][1]), "+v"(gtv[0][2]), "+v"(gtv[0][3]), "+v"(gtv[1][0]), "+v"(gtv[1][1]), "+v"(gtv[1][2]), "+v"(gtv[1][3]) :: "memory");
#pragma unroll
        for (int ai = 0; ai < 2; ++ai)
#pragma unroll
            for (int m = 0; m < 4; ++m) { const int r = row0 + ai * 128 + m * 16; const float gt = gtv[ai][m]; bf16_t* rowp = YE + (size_t)r * D + col0;
#pragma unroll
                for (int bj = 0; bj < 2; ++bj) { const f32x4 v0 = acc[ai][bj][m][0] * gt, v1 = acc[ai][bj][m][1] * gt;
                    u32x4 w; w.x = pk2c(v0[0], v0[1]); w.y = pk2c(v0[2], v0[3]); w.z = pk2c(v1[0], v1[1]); w.w = pk2c(v1[2], v1[3]);
                    *(u32x4*)(rowp + bj * CBJ) = w; } }
    }
};
struct EpiMla {
    static constexpr bool PERM = true, WIDE = EPI_WIDE;
    bf16_t* Q; bf16_t* KF; bf16_t* VF; const float* rinv; const f32x2* rope;
    __device__ __forceinline__ void operator()(const AccT& acc, const pg8::Unit& u, int wr, int wc, int fr, int fq) const {
        const int row0 = u.pm * 256 + wr * 64 + fr;
        float riv[2][4];
#pragma unroll
        for (int ai = 0; ai < 2; ++ai)
#pragma unroll
            for (int m = 0; m < 4; ++m) riv[ai][m] = rinv[(u.z == 0 ? 0 : R) + row0 + ai * 128 + m * 16];
        asm volatile("" : "+v"(riv[0][0]), "+v"(riv[0][1]), "+v"(riv[0][2]), "+v"(riv[0][3]), "+v"(riv[1][0]), "+v"(riv[1][1]), "+v"(riv[1][2]), "+v"(riv[1][3]) :: "memory");
        if (u.z == 0) {
#pragma unroll
            for (int bj = 0; bj < 2; ++bj) { const int c8 = u.pn * 256 + bj * CBJ + wc * CW + 8 * fq, h = c8 / 192, dd = c8 % 192;
                const bool rot = dd >= 128; const int i0 = rot ? ((dd - 128) >> 1) : 0;
                const bool anyrot = __builtin_amdgcn_ballot_w64(rot) != 0ull;
#pragma unroll
                for (int ai = 0; ai < 2; ++ai) {
                    f32x4 cs0[4], cs1[4];
                    if (anyrot) {
#pragma unroll
                        for (int m = 0; m < 4; ++m) { const int t = (row0 + ai * 128 + m * 16) & 4095; cs0[m] = *(const f32x4*)(rope + t * 32 + i0); cs1[m] = *(const f32x4*)(rope + t * 32 + i0 + 2); }
                        asm volatile("" : "+v"(cs0[0]), "+v"(cs0[1]), "+v"(cs0[2]), "+v"(cs0[3]), "+v"(cs1[0]), "+v"(cs1[1]), "+v"(cs1[2]), "+v"(cs1[3]) :: "memory");
                    } else {
#pragma unroll
                        for (int m = 0; m < 4; ++m) { cs0[m] = (f32x4){1.f, 0.f, 1.f, 0.f}; cs1[m] = cs0[m]; } }
#pragma unroll
                    for (int m = 0; m < 4; ++m) { const int r = row0 + ai * 128 + m * 16, b = r >> 12, t = r & 4095; const float ri = riv[ai][m];
                        f32x4 v0 = acc[ai][bj][m][0] * ri, v1 = acc[ai][bj][m][1] * ri;
                        if (rot) { const f32x4 a = v0, c = v1, e0 = cs0[m], e1 = cs1[m];
                            v0[0] = a[0] * e0[0] - a[1] * e0[1]; v0[1] = a[0] * e0[1] + a[1] * e0[0]; v0[2] = a[2] * e0[2] - a[3] * e0[3]; v0[3] = a[2] * e0[3] + a[3] * e0[2];
                            v1[0] = c[0] * e1[0] - c[1] * e1[1]; v1[1] = c[0] * e1[1] + c[1] * e1[0]; v1[2] = c[2] * e1[2] - c[3] * e1[3]; v1[3] = c[2] * e1[3] + c[3] * e1[2]; }
                        u32x4 w; w.x = pk2c(v0[0], v0[1]); w.y = pk2c(v0[2], v0[3]); w.z = pk2c(v1[0], v1[1]); w.w = pk2c(v1[2], v1[3]);
                        *(u32x4*)(Q + ((size_t)((b * 8 + h) * TL + t)) * 192 + dd) = w; } } }
        } else {
            const int h = u.pn;
#pragma unroll
            for (int ai = 0; ai < 2; ++ai)
#pragma unroll
                for (int m = 0; m < 4; ++m) { const int r = row0 + ai * 128 + m * 16; const float ri = riv[ai][m];
                    int b, pos; if (r < RL) { b = r >> 12; pos = TC + (r & 4095); } else { b = (r - RL) >> 8; pos = (r - RL) & 255; }
                    const size_t kv = (size_t)((b * 8 + h) * KSEQ + pos);
#pragma unroll
                    for (int bj = 0; bj < 2; ++bj) { const f32x4 v0 = acc[ai][bj][m][0] * ri, v1 = acc[ai][bj][m][1] * ri;
                        u32x4 w; w.x = pk2c(v0[0], v0[1]); w.y = pk2c(v0[2], v0[3]); w.z = pk2c(v1[0], v1[1]); w.w = pk2c(v1[2], v1[3]);
                        const int ct = wc * CW + bj * CBJ + 8 * fq;
                        if (ct < 128) *(u32x4*)(KF + kv * 192 + ct) = w; else *(u32x4*)(VF + kv * 128 + ct - 128) = w; } }
        }
    }
};
__device__ __forceinline__ void phase_router(const Frame& F, int l, int nrows) {
    LAS f32x4* WR = (LAS f32x4*)F.lds;
    LAS float* NWS = (LAS float*)(F.lds + LDS_XTRA); LAS float* SHL = NWS + 2048;
    const float* wr = F.in[I_ROUT] + (size_t)l * D * NE;
    for (int i = F.tid; i < 2048 * 4; i += NTHR) { const int d = i >> 2, e4 = i & 3; const int j = d >> 9, lane_ = (d >> 3) & 63, q = d & 7;
        WR[e4 * 2048 + (j * 8 + q) * 64 + lane_] = *(const f32x4*)(wr + (size_t)d * NE + e4 * 4); }
    const float* nf = F.in[I_NFFN] + (size_t)l * D; const bf16_t* XA = F.w<const bf16_t>(WS_XA); const bf16_t* DL = F.w<const bf16_t>(WS_DELTA);
    auto load_base = [&](int r, float (&o)[32]) { if (l == 0) load_row_f32(x_in_row(F, r), F.lane, o); else load_row_bf16(XA + (size_t)r * D, F.lane, o); };
    u32x4 dn[4];
#define LOAD_DELTA(r_, d_) do { _Pragma("unroll") for (int j_ = 0; j_ < 4; ++j_) (d_)[j_] = *(const u32x4*)(DL + (size_t)(r_) * D + (j_ * 64 + F.lane) * 8); } while (0)
    const int per = (nrows + F.G - 1) / F.G, r0 = xcd_chunk(F) * per, r1 = (r0 + per < nrows) ? r0 + per : nrows;
    int cur = -1; float vn[32];
    { const int r = r0 + F.wave; if (r < r1) { load_base(r, vn); LOAD_DELTA(r, dn); } }
    const int hi5 = (F.lane >> 5) & 1, hi4 = (F.lane >> 4) & 1, hi3 = (F.lane >> 3) & 1, hi2 = (F.lane >> 2) & 1, myexp = 8 * hi5 + 4 * hi4 + 2 * hi3 + hi2;
    for (int rb = r0; rb < r1; rb += NWAVES) {
        const int r = rb + F.wave;
        const int bs_first = row_bsel(rb), bs_last = row_bsel((rb + NWAVES - 1 < r1 ? rb + NWAVES - 1 : r1 - 1));
        float v[32];
#pragma unroll
        for (int j = 0; j < 4; ++j) { float o8[8]; unpack8(dn[j], o8);
#pragma unroll
            for (int q = 0; q < 8; ++q) v[8 * j + q] = vn[8 * j + q] + o8[q]; }
        if (r < r1) store_row_bf16(F.w<bf16_t>(WS_X1B) + (size_t)r * D, F.lane, v);
        { const int rn = r + NWAVES; if (rn < r1) { load_base(rn, vn); LOAD_DELTA(rn, dn); } }
        for (int pass = 0; pass < (bs_first == bs_last ? 1 : 2); ++pass) {
            const int bs = pass == 0 ? bs_first : bs_last;
            if (bs != cur) {
                __syncthreads();
                for (int i = F.tid; i < 2048; i += NTHR) { NWS[i] = nf[i] * (1.0f + mod_ptr(F, l, bs, 4)[i]); SHL[i] = mod_ptr(F, l, bs, 3)[i]; }
                __syncthreads();
                cur = bs;
            }
            if (r < r1 && row_bsel(r) == bs) {
                float ss = 0.f;
#pragma unroll
                for (int i = 0; i < 32; ++i) ss += v[i] * v[i];
                const float rinv = rsqrtf(wave_sum(ss) * (1.0f / D) + EPS);
                float lg[16];
#pragma unroll
                for (int e = 0; e < 16; ++e) lg[e] = 0.f;
#pragma unroll
                for (int j = 0; j < 4; ++j) { const f32x4 na = *(const LAS f32x4*)(NWS + (j * 64 + F.lane) * 8), nb = *(const LAS f32x4*)(NWS + (j * 64 + F.lane) * 8 + 4);
                    const f32x4 ha = *(const LAS f32x4*)(SHL + (j * 64 + F.lane) * 8), hb = *(const LAS f32x4*)(SHL + (j * 64 + F.lane) * 8 + 4);
#pragma unroll
                    for (int q = 0; q < 8; ++q) { const float h = v[8 * j + q] * rinv * (q < 4 ? na[q & 3] : nb[q & 3]) + (q < 4 ? ha[q & 3] : hb[q & 3]); v[8 * j + q] = h;
#pragma unroll
                        for (int e4 = 0; e4 < 4; ++e4) { const f32x4 w = WR[e4 * 2048 + (j * 8 + q) * 64 + F.lane]; lg[4 * e4 + 0] += h * w[0]; lg[4 * e4 + 1] += h * w[1]; lg[4 * e4 + 2] += h * w[2]; lg[4 * e4 + 3] += h * w[3]; } } }
                store_row_bf16(F.w<bf16_t>(WS_H) + (size_t)r * D, F.lane, v);
                float r8[8], r4[4], r2[2], r1v;
#pragma unroll
                for (int i = 0; i < 8; ++i) { const float mine = hi5 ? lg[8 + i] : lg[i], oth = hi5 ? lg[i] : lg[8 + i]; r8[i] = mine + __shfl_xor(oth, 32); }
#pragma unroll
                for (int i = 0; i < 4; ++i) { const float mine = hi4 ? r8[4 + i] : r8[i], oth = hi4 ? r8[i] : r8[4 + i]; r4[i] = mine + __shfl_xor(oth, 16); }
#pragma unroll
                for (int i = 0; i < 2; ++i) { const float mine = hi3 ? r4[2 + i] : r4[i], oth = hi3 ? r4[i] : r4[2 + i]; r2[i] = mine + __shfl_xor(oth, 8); }
                { const float mine = hi2 ? r2[1] : r2[0], oth = hi2 ? r2[0] : r2[1]; r1v = mine + __shfl_xor(oth, 4); }
                r1v += __shfl_xor(r1v, 2); r1v += __shfl_xor(r1v, 1);
                float mx = r1v;
                mx = fmaxf(mx, __shfl_xor(mx, 4)); mx = fmaxf(mx, __shfl_xor(mx, 8)); mx = fmaxf(mx, __shfl_xor(mx, 16)); mx = fmaxf(mx, __shfl_xor(mx, 32));
                const float ex = expf(r1v - mx); float sm = ex;
                sm += __shfl_xor(sm, 4); sm += __shfl_xor(sm, 8); sm += __shfl_xor(sm, 16); sm += __shfl_xor(sm, 32);
                const float aff = ex / sm;
                if ((F.lane & 3) == 0) { if (r < RL) F.w<float>(WS_AFFL)[((size_t)((r >> 12) * NE + myexp)) * TL + (r & 4095)] = aff;
                                         else { const int rc = r - RL; F.w<float>(WS_AFFC)[((size_t)((rc >> 8) * NE + myexp)) * TC + (rc & 255)] = aff; } }
            }
        }
    }
}

__device__ __forceinline__ void phase_topk(const Frame& F, int nunits, int mrows) {
    LAS unsigned* hist = (LAS unsigned*)F.lds;
    LAS unsigned* ctl = hist + 8 * 257 + 7;
    LAS unsigned* wtot = ctl + 8;
    for (int u = F.bid; u < nunits; u += F.G) {
        const bool isc = u >= 64; const int be = isc ? u - 64 : u, T = isc ? TC : TL, cap = isc ? CAPC : CAPL;
        const float* src = (isc ? F.w<const float>(WS_AFFC) : F.w<const float>(WS_AFFL)) + (size_t)be * T;
        unsigned key[8];
        if (F.tid * 8 < T) { const u32x4 a = *(const u32x4*)(src + F.tid * 8), b = *(const u32x4*)(src + F.tid * 8 + 4); key[0] = a.x; key[1] = a.y; key[2] = a.z; key[3] = a.w; key[4] = b.x; key[5] = b.y; key[6] = b.z; key[7] = b.w; }
        else {
#pragma unroll
            for (int i = 0; i < 8; ++i) key[i] = 0u; }
        unsigned prefix = 0u, mask = 0u, k = (unsigned)cap;
#pragma unroll 1
        for (int shift = 24; shift >= 0; shift -= 8) {
            __syncthreads();
            for (int i = F.tid; i < 8 * 257; i += NTHR) hist[i] = 0u;
            __syncthreads();
#pragma unroll
            for (int i = 0; i < 8; ++i) if ((key[i] & mask) == prefix && key[i] != 0u) __hip_atomic_fetch_add(&hist[F.wave * 257 + ((key[i] >> shift) & 255u)], 1u, __ATOMIC_RELAXED, __HIP_MEMORY_SCOPE_WORKGROUP);
            __syncthreads();
            if (F.wave == 0) {
                unsigned c0 = 0u, c1 = 0u, c2 = 0u, c3 = 0u;
#pragma unroll
                for (int w8 = 0; w8 < 8; ++w8) { c0 += hist[w8 * 257 + 4 * F.lane]; c1 += hist[w8 * 257 + 4 * F.lane + 1]; c2 += hist[w8 * 257 + 4 * F.lane + 2]; c3 += hist[w8 * 257 + 4 * F.lane + 3]; }
                const unsigned s = c0 + c1 + c2 + c3;
                unsigned incl = s;
#pragma unroll
                for (int o = 1; o < 64; o <<= 1) { const unsigned t = __shfl_down(incl, o); if (F.lane + o < 64) incl += t; }
                const unsigned suf = incl - s;
                if (suf < k && k <= suf + s) {
                    unsigned cum = suf; int bin; unsigned nk;
                    if (cum + c3 >= k) { bin = 3; nk = k - cum; } else { cum += c3;
                    if (cum + c2 >= k) { bin = 2; nk = k - cum; } else { cum += c2;
                    if (cum + c1 >= k) { bin = 1; nk = k - cum; } else { cum += c1; bin = 0; nk = k - cum; } } }
                    ctl[0] = (unsigned)(4 * F.lane + bin); ctl[1] = nk;
                }
            }
            __syncthreads();
            prefix |= ctl[0] << shift; mask |= 255u << shift; k = ctl[1];
        }
        const unsigned thr = prefix, keq = k;
        unsigned cg = 0, ce = 0;
#pragma unroll
        for (int i = 0; i < 8; ++i) { cg += key[i] > thr; ce += key[i] == thr; }
        unsigned pk = cg | (ce << 16), inc = pk;
#pragma unroll
        for (int o = 1; o < 64; o <<= 1) { const unsigned t = __shfl_up(inc, o); if (F.lane >= o) inc += t; }
        __syncthreads();
        if (F.lane == 63) wtot[F.wave] = inc;
        __syncthreads();
        unsigned base = 0, total = 0;
#pragma unroll
        for (int w = 0; w < NWAVES; ++w) { const unsigned t = wtot[w]; if (w < F.wave) base += t; total += t; }
        const unsigned excl = base + inc - pk;
        unsigned grun = excl & 0xffffu, erun = excl >> 16; const unsigned ngt = total & 0xffffu;
        const int b = be >> 4, e = be & 15;
        const int mbase = e * mrows + (isc ? 2048 + b * CAPC : b * CAPL), rbase = isc ? RL + b * TC : b * TL;
        int* idx = F.w<int>(WS_ROWMAP) + mbase; float* gat = F.w<float>(WS_GROW) + mbase;
        int* pos = F.w<int>(WS_POS) + (size_t)e * R + rbase;
        if (isc && b == 0 && F.tid < 128) { F.w<int>(WS_ROWMAP)[e * mrows + 2176 + F.tid] = R; F.w<float>(WS_GROW)[e * mrows + 2176 + F.tid] = 0.f; }
        if (F.tid * 8 < T) {
#pragma unroll
            for (int hq = 0; hq < 2; ++hq) { u32x4 sv;
#pragma unroll
                for (int i4 = 0; i4 < 4; ++i4) { const int i = hq * 4 + i4, t = F.tid * 8 + i; int slot = -1;
                    if (key[i] > thr) slot = (int)grun++;
                    else if (key[i] == thr) { if (erun < keq) slot = (int)(ngt + erun); ++erun; }
                    if (slot >= 0) { idx[slot] = rbase + t; gat[slot] = __uint_as_float(key[i]); }
                    sv[i4] = (unsigned)slot; }
                *(u32x4*)(pos + F.tid * 8 + hq * 4) = sv; }
        }
    }
}

__device__ __forceinline__ void phase_combine(const Frame& F, int l, int nrows, int mrows, bool last) {
    const float* nw = last ? F.in[I_FN] : F.in[I_NMIX] + (size_t)(l + 1) * D;
    LAS float* G2 = (LAS float*)F.lds; LAS float* NWS = G2 + 2048; LAS float* SHL = NWS + 2048;
    const int per = (nrows + F.G - 1) / F.G, r0 = xcd_chunk(F) * per, r1 = (r0 + per < nrows) ? r0 + per : nrows;
    const bf16_t* X1 = F.w<const bf16_t>(WS_X1B); const int* POS = F.w<const int>(WS_POS); const bf16_t* YE = F.w<const bf16_t>(WS_YE);
    int cur = -1;
    float vn[32]; int sn = -1;
    { const int r = r0 + F.wave; if (r < r1) { load_row_bf16(X1 + (size_t)r * D, F.lane, vn); if (F.lane < 16) sn = POS[(size_t)F.lane * R + r]; } }
    for (int rb = r0; rb < r1; rb += NWAVES) {
        const int r = rb + F.wave;
        const int bs_first = row_bsel(rb), bs_last = row_bsel((rb + NWAVES - 1 < r1 ? rb + NWAVES - 1 : r1 - 1));
        float v[32]; int spos = sn;
#pragma unroll
        for (int i = 0; i < 32; ++i) v[i] = vn[i];
        { const int rn = r + NWAVES; sn = -1; if (rn < r1) { load_row_bf16(X1 + (size_t)rn * D, F.lane, vn); if (F.lane < 16) sn = POS[(size_t)F.lane * R + rn]; } }
        for (int pass = 0; pass < (bs_first == bs_last ? 1 : 2); ++pass) {
            const int bs = pass == 0 ? bs_first : bs_last;
            if (bs != cur) {
                __syncthreads();
                for (int i = F.tid; i < 2048; i += NTHR) { G2[i] = mod_ptr(F, l, bs, 5)[i];
                    if (last) { NWS[i] = nw[i]; SHL[i] = 0.f; } else { NWS[i] = nw[i] * (1.0f + mod_ptr(F, l + 1, bs, 1)[i]); SHL[i] = mod_ptr(F, l + 1, bs, 0)[i]; } }
                __syncthreads();
                cur = bs;
            }
            if (r < r1 && row_bsel(r) == bs) {
                float a[32];
#pragma unroll
                for (int i = 0; i < 32; ++i) a[i] = 0.f;
                const int mbase = r < RL ? (r >> 12) * CAPL : 2048 + ((r - RL) >> 8) * CAPC;
                unsigned long long m = __ballot(F.lane < 16 && spos >= 0);
#pragma unroll 1
                while (m) {
                    const int e0 = __builtin_ctzll(m); m &= m - 1; const bool two = (m != 0ull); const int e1 = two ? __builtin_ctzll(m) : e0; if (two) m &= m - 1;
                    const int s0 = __shfl(spos, e0), s1 = __shfl(spos, e1);
                    const u32x4* y0 = (const u32x4*)(YE + ((size_t)e0 * mrows + mbase + s0) * D); const u32x4* y1 = (const u32x4*)(YE + ((size_t)e1 * mrows + mbase + s1) * D);
                    u32x4 w0[4], w1[4];
#pragma unroll
                    for (int j = 0; j < 4; ++j) { w0[j] = y0[j * 64 + F.lane]; w1[j] = y1[j * 64 + F.lane]; }
#pragma unroll
                    for (int j = 0; j < 4; ++j) { float o[8]; unpack8(w0[j], o);
#pragma unroll
                        for (int q = 0; q < 8; ++q) a[8 * j + q] += o[q];
                        if (two) { unpack8(w1[j], o);
#pragma unroll
                            for (int q = 0; q < 8; ++q) a[8 * j + q] += o[q]; } }
                }
#pragma unroll
                for (int j = 0; j < 4; ++j) { const f32x4 ga = *(const LAS f32x4*)(G2 + (j * 64 + F.lane) * 8), gb = *(const LAS f32x4*)(G2 + (j * 64 + F.lane) * 8 + 4);
#pragma unroll
                    for (int q = 0; q < 4; ++q) { v[8 * j + q] += ga[q] * a[8 * j + q]; v[8 * j + 4 + q] += gb[q] * a[8 * j + 4 + q]; } }
                if (!last) store_row_bf16(F.w<bf16_t>(WS_XA) + (size_t)r * D, F.lane, v);
                float ss = 0.f;
#pragma unroll
                for (int i = 0; i < 32; ++i) ss += v[i] * v[i];
                const float rinv = rsqrtf(wave_sum(ss) * (1.0f / D) + EPS);
#pragma unroll
                for (int j = 0; j < 4; ++j) { const f32x4 na = *(const LAS f32x4*)(NWS + (j * 64 + F.lane) * 8), nb = *(const LAS f32x4*)(NWS + (j * 64 + F.lane) * 8 + 4);
                    const f32x4 ha = *(const LAS f32x4*)(SHL + (j * 64 + F.lane) * 8), hb = *(const LAS f32x4*)(SHL + (j * 64 + F.lane) * 8 + 4);
#pragma unroll
                    for (int q = 0; q < 4; ++q) { v[8 * j + q] = v[8 * j + q] * rinv * na[q] + ha[q]; v[8 * j + 4 + q] = v[8 * j + 4 + q] * rinv * nb[q] + hb[q]; } }
                if (last) store_row_f32(F.out + (size_t)r * D, F.lane, v); else store_row_bf16(F.w<bf16_t>(WS_H) + (size_t)r * D, F.lane, v);
            }
        }
    }
}
__device__ __forceinline__ int step_row(int s, int b, int d) {
    if (s < TC) { const int tc = d ? (TC - 1 - s) : s; return RL + b * TC + tc; }
    const int tl = s - TC, t = d ? (TL - 1 - tl) : tl; return b * TL + t;
}
constexpr int U0_Q = 0, U0_G = 1024, U0_LG = 2048, U0_FF = 3072, U0_FB = 4096, U0_I = 5120, U0_LX = 6144;

__device__ __forceinline__ void phase_lru_gates(const Frame& F) {
    LAS bf16_t* LXS = (LAS bf16_t*)F.lds;
    LAS bf16_t* XCB = LXS + 68 * 128;
    LAS bf16_t* OUT = XCB + 64 * 136;
    const bf16_t* U0 = F.w<const bf16_t>(WS_U0);
    const int hb = F.bid & 7, w = F.wave, l15 = F.lane & 15, l4 = F.lane >> 4;
    const int nper = F.G >> 3;
    if ((F.G & 7) != 0 || nper == 0) return;
    bf16x8 bw[4][4];
    { const bf16_t* WL = F.w<const bf16_t>(WS_WL);
#pragma unroll
      for (int mat = 0; mat < 4; ++mat)
#pragma unroll
          for (int ks = 0; ks < 4; ++ks) bw[mat][ks] = *(const bf16x8*)(WL + ((size_t)(mat * 8 + hb) * 128 + 16 * w + l15) * 128 + ks * 32 + 8 * l4); }
    const int ch = hb * 128 + 16 * w + l15;
    float cba[2], cbx[2], csp[2];
#pragma unroll
    for (int d = 0; d < 2; ++d) { cba[d] = F.in[I_LBA][d * 1024 + ch]; cbx[d] = F.in[I_LBX][d * 1024 + ch]; csp[d] = -8.0f * softplusf_(-F.in[I_LLAM][d * 1024 + ch]); }
    const int cc = F.tid & 127, chc = hb * 128 + cc; const float* cw = F.in[I_LCW];
    const float w0 = cw[chc], w1 = cw[1024 + chc], w2 = cw[2048 + chc], w3 = cw[3072 + chc], cb = F.in[I_LCB][chc];
    u32x4 pre[3];
    auto tile_geom = [&](int rb_, int& rowbase_, int& t0_, int& T_) {
        if (rb_ < RL / 64) { const int b = rb_ >> 6; t0_ = (rb_ & 63) * 64; T_ = TL; rowbase_ = b * TL; } else { const int rc = rb_ - RL / 64, b = rc >> 2; t0_ = (rc & 3) * 64; T_ = TC; rowbase_ = RL + b * TC; } };
    auto fetch = [&](int rb_) { int rowbase_, t0_, T_; tile_geom(rb_, rowbase_, t0_, T_);
#pragma unroll
        for (int q = 0; q < 3; ++q) { const int c = F.tid + NTHR * q, rr = c >> 4, c8 = (c & 15) * 8, t = t0_ - 2 + rr; const bool ok = c < 67 * 16 && t >= 0 && t < T_;
            const u32x4 v = *(const u32x4*)(U0 + (size_t)(rowbase_ + (ok ? t : t0_)) * EVN + U0_LX + hb * 128 + c8);
            pre[q] = ok ? v : (u32x4){0u, 0u, 0u, 0u}; } };
    if ((F.bid >> 3) < R / 64) fetch(F.bid >> 3);
    for (int rb = F.bid >> 3; rb < R / 64; rb += nper) {
        int rowbase, t0, T; tile_geom(rb, rowbase, t0, T);
        __syncthreads();
#pragma unroll
        for (int q = 0; q < 3; ++q) { const int c = F.tid + NTHR * q, rr = c >> 4, c8 = (c & 15) * 8; if (c < 67 * 16) *(LAS u32x4*)(LXS + rr * 128 + c8) = pre[q]; }
        if (rb + nper < R / 64) fetch(rb + nper);
        __syncthreads();
        { const int tq = F.tid >> 7; float x0 = bf2f(LXS[(16 * tq) * 128 + cc]), x1 = bf2f(LXS[(16 * tq + 1) * 128 + cc]), x2 = bf2f(LXS[(16 * tq + 2) * 128 + cc]);
#pragma unroll
          for (int i = 0; i < 16; ++i) { const int tt = 16 * tq + i; const float x3 = bf2f(LXS[(tt + 3) * 128 + cc]);
              XCB[tt * 136 + cc] = f2bf(w0 * x0 + w1 * x1 + w2 * x2 + w3 * x3 + cb); x0 = x1; x1 = x2; x2 = x3; } }
        __syncthreads();
#pragma unroll 1
        for (int mt = 0; mt < 4; ++mt) {
            bf16x8 af[4];
#pragma unroll
            for (int ks = 0; ks < 4; ++ks) af[ks] = *(const LAS bf16x8*)(XCB + (mt * 16 + l15) * 136 + ks * 32 + 8 * l4);
            f32x4 acc[4];
#pragma unroll
            for (int mat = 0; mat < 4; ++mat) { acc[mat] = (f32x4){0.f, 0.f, 0.f, 0.f};
#pragma unroll
                for (int ks = 0; ks < 4; ++ks) acc[mat] = __builtin_amdgcn_mfma_f32_16x16x32_bf16(af[ks], bw[mat][ks], acc[mat], 0, 0, 0); }
#pragma unroll
            for (int j = 0; j < 4; ++j) { const int tt = mt * 16 + l4 * 4 + j; const float xc = bf2f(XCB[tt * 136 + 16 * w + l15]);
#pragma unroll
                for (int d = 0; d < 2; ++d) { const float r = sigmoidf_(acc[d * 2 + 0][j] + cba[d]), ig = sigmoidf_(acc[d * 2 + 1][j] + cbx[d]);
                    const float la = r * csp[d], bb = __builtin_amdgcn_sqrtf(1.0f - __expf(2.0f * la)) * ig * xc;
                    OUT[((d * 2 + 0) * 64 + tt) * 128 + 16 * w + l15] = f2bf(la); OUT[((d * 2 + 1) * 64 + tt) * 128 + 16 * w + l15] = f2bf(bb); } }
        }
        __syncthreads();
#pragma unroll
        for (int q = 0; q < 8; ++q) { const int p = F.tid + NTHR * q, arr = p >> 10, tt = (p >> 4) & 63, c8 = (p & 15) * 8, d = arr >> 1;
            bf16_t* dst = (arr & 1) ? F.w<bf16_t>(WS_BB) : F.w<bf16_t>(WS_LA);
            *(u32x4*)(dst + ((size_t)d * R + rowbase + t0 + tt) * 1024 + hb * 128 + c8) = *(const LAS u32x4*)(OUT + (arr * 64 + tt) * 128 + c8); }
    }
}

__device__ __forceinline__ void lru_scan_unit(const Frame& F, int u) {
    const int b = u >> 5, cg = (u >> 1) & 15, d = u & 1, cl = F.lane & 15, sg = F.lane >> 4, seg = F.wave * 4 + sg, ch = cg * 64 + 4 * cl;
    LAS float* HE = (LAS float*)F.lds; LAS float* AT = HE + 2 * 32 * 64; LAS float* CR = AT + 2 * 32 * 64;
    const bf16_t* LA = F.w<const bf16_t>(WS_LA) + (size_t)d * R * 1024 + ch; const bf16_t* BB = F.w<const bf16_t>(WS_BB) + (size_t)d * R * 1024 + ch;
    bf16_t* HD = F.w<bf16_t>(WS_HD) + (size_t)d * R * 1024 + ch;
    constexpr int TBS = 256, SL = 8, NTB = KSEQ / TBS;
    static_assert(NTB * TBS == KSEQ && TBS == 32 * SL && TC == TBS, "lru blocks: a block never straddles the context / latent boundary, so its rows are consecutive");
    const long sgn = d ? -1024l : 1024l;
    if (F.tid < 128) CR[F.tid] = 0.f;
    __syncthreads();
#pragma unroll 1
    for (int tb = 0; tb < NTB; ++tb) {
        const size_t o0 = (size_t)step_row(tb * TBS + seg * SL, b, d) * 1024;
        u32x2 la[SL], bb[SL];
#pragma unroll
        for (int i = 0; i < SL; ++i) { la[i] = *(const u32x2*)(LA + o0 + (long)i * sgn); bb[i] = *(const u32x2*)(BB + o0 + (long)i * sgn); }
        float h[4] = {0.f, 0.f, 0.f, 0.f}, A[4] = {0.f, 0.f, 0.f, 0.f};
#pragma unroll
        for (int i = 0; i < SL; ++i) { const float l0 = bflo(la[i].x), l1 = bfhi(la[i].x), l2 = bflo(la[i].y), l3 = bfhi(la[i].y);
            h[0] = __expf(l0) * h[0] + bflo(bb[i].x); h[1] = __expf(l1) * h[1] + bfhi(bb[i].x); h[2] = __expf(l2) * h[2] + bflo(bb[i].y); h[3] = __expf(l3) * h[3] + bfhi(bb[i].y);
            A[0] += l0; A[1] += l1; A[2] += l2; A[3] += l3; }
        LAS float* he = HE + (tb & 1) * 2048; LAS float* at = AT + (tb & 1) * 2048;
        *(LAS f32x4*)(he + seg * 64 + 4 * cl) = (f32x4){h[0], h[1], h[2], h[3]}; *(LAS f32x4*)(at + seg * 64 + 4 * cl) = (f32x4){A[0], A[1], A[2], A[3]};
        __syncthreads();
        { const f32x4 c4 = *(const LAS f32x4*)(CR + (tb & 1) * 64 + 4 * cl); h[0] = c4[0]; h[1] = c4[1]; h[2] = c4[2]; h[3] = c4[3]; }
        for (int s2 = 0; s2 < seg; ++s2) { const f32x4 a4 = *(const LAS f32x4*)(at + s2 * 64 + 4 * cl), h4 = *(const LAS f32x4*)(he + s2 * 64 + 4 * cl);
#pragma unroll
            for (int q = 0; q < 4; ++q) h[q] = __expf(a4[q]) * h[q] + h4[q]; }
#pragma unroll
        for (int i = 0; i < SL; ++i) {
            h[0] = __expf(bflo(la[i].x)) * h[0] + bflo(bb[i].x); h[1] = __expf(bfhi(la[i].x)) * h[1] + bfhi(bb[i].x); h[2] = __expf(bflo(la[i].y)) * h[2] + bflo(bb[i].y); h[3] = __expf(bfhi(la[i].y)) * h[3] + bfhi(bb[i].y);
            u32x2 o2; o2.x = pk2c(h[0], h[1]); o2.y = pk2c(h[2], h[3]); *(u32x2*)(HD + o0 + (long)i * sgn) = o2; }
        if (seg == 31) *(LAS f32x4*)(CR + ((tb + 1) & 1) * 64 + 4 * cl) = (f32x4){h[0], h[1], h[2], h[3]};
    }
}

__device__ __forceinline__ void lru_fused_unit(const Frame& F, int u) {
    const int b = u >> 5, cg = (u >> 1) & 15, d = u & 1, hb = cg >> 1, ch0 = (cg & 1) * 64;
    constexpr int BS = 128, NBK = KSEQ / BS;
    static_assert(NBK * BS == KSEQ && TC % BS == 0, "lru blocks");
    LAS bf16_t* LXS = (LAS bf16_t*)F.lds;
    LAS bf16_t* XCB = LXS + 131 * 128;
    LAS bf16_t* LAB = XCB + 128 * 136;
    LAS bf16_t* BBB = LAB + 128 * 64;
    LAS float* HE = (LAS float*)(BBB + 128 * 64);
    LAS float* AT = HE + 32 * 64;
    LAS float* CR = AT + 32 * 64;
    LAS float* WH = CR + 2 * 64; LAS float* WA = WH + 8 * 64;
    const bf16_t* U0 = F.w<const bf16_t>(WS_U0);
    bf16_t* HD = F.w<bf16_t>(WS_HD) + (size_t)d * R * 1024 + hb * 128 + ch0;
    const int w = F.wave, l15 = F.lane & 15, l4 = F.lane >> 4, nt = w & 3, mh = w >> 2;
    const int cl = F.lane & 15, sg = F.lane >> 4, seg = w * 4 + sg;
    bf16x8 bwa[4], bwx[4];
    { const bf16_t* WL = F.w<const bf16_t>(WS_WL); const int n = ch0 + 16 * nt + l15;
#pragma unroll
      for (int ks = 0; ks < 4; ++ks) { bwa[ks] = *(const bf16x8*)(WL + ((size_t)((d * 2 + 0) * 8 + hb) * 128 + n) * 128 + ks * 32 + 8 * l4); bwx[ks] = *(const bf16x8*)(WL + ((size_t)((d * 2 + 1) * 8 + hb) * 128 + n) * 128 + ks * 32 + 8 * l4); } }
    const int chg = hb * 128 + ch0 + 16 * nt + l15;
    const float cba = F.in[I_LBA][d * 1024 + chg], cbx = F.in[I_LBX][d * 1024 + chg], csp = -8.0f * softplusf_(-F.in[I_LLAM][d * 1024 + chg]);
    const int c8 = (F.tid & 15) * 8, r4 = (F.tid >> 4) * 4;
    auto geom = [&](int kb, int& rowbase_, int& tlo_, int& T_) { const int s0 = kb * BS;
        if (s0 < TC) { T_ = TC; rowbase_ = RL + b * TC; tlo_ = d ? (TC - BS - s0) : s0; } else { const int tl0 = s0 - TC; T_ = TL; rowbase_ = b * TL; tlo_ = d ? (TL - BS - tl0) : tl0; } };
    u32x4 pre[5];
    auto fetch = [&](int kb) { int rowbase_, tlo_, T_; geom(kb, rowbase_, tlo_, T_);
#pragma unroll
        for (int q = 0; q < 5; ++q) { const int c = F.tid + NTHR * q, rr = c >> 4, c8 = (c & 15) * 8, t = tlo_ - 2 + rr; const bool ok = c < 131 * 16 && t >= 0 && t < T_;
            const u32x4 v = *(const u32x4*)(U0 + (size_t)(rowbase_ + (ok ? t : tlo_)) * EVN + U0_LX + hb * 128 + c8);
            pre[q] = ok ? v : (u32x4){0u, 0u, 0u, 0u}; } };
    if (F.tid < 128) CR[F.tid] = 0.f;
    fetch(0);
#pragma unroll 1
    for (int kb = 0; kb < NBK; ++kb) {
        int rowbase, tlo, T; geom(kb, rowbase, tlo, T);
        __syncthreads();
#pragma unroll
        for (int q = 0; q < 5; ++q) { const int c = F.tid + NTHR * q, rr = c >> 4, c8 = (c & 15) * 8; if (c < 131 * 16) *(LAS u32x4*)(LXS + rr * 128 + c8) = pre[q]; }
        if (kb + 1 < NBK) fetch(kb + 1);
        __syncthreads();
#pragma unroll 1
        for (int h2 = 0; h2 < 2; ++h2) { const int c4 = c8 + 4 * h2;
            f32x4 cwv[4];
#pragma unroll
            for (int k = 0; k < 4; ++k) cwv[k] = *(const f32x4*)(F.in[I_LCW] + k * 1024 + hb * 128 + c4);
            const f32x4 cbv = *(const f32x4*)(F.in[I_LCB] + hb * 128 + c4);
            f32x4 xin[7];
#pragma unroll
            for (int k = 0; k < 7; ++k) { const u32x2 v = *(const LAS u32x2*)(LXS + (r4 + k) * 128 + c4); xin[k] = (f32x4){bflo(v.x), bfhi(v.x), bflo(v.y), bfhi(v.y)}; }
#pragma unroll
            for (int rr = 0; rr < 4; ++rr) { const f32x4 o = cwv[0] * xin[rr] + cwv[1] * xin[rr + 1] + cwv[2] * xin[rr + 2] + cwv[3] * xin[rr + 3] + cbv;
                u32x2 ow; ow.x = pk2c(o[0], o[1]); ow.y = pk2c(o[2], o[3]);
                *(LAS u32x2*)(XCB + (r4 + rr) * 136 + c4) = ow; } }
        __syncthreads();
#pragma unroll 1
        for (int mi = 0; mi < 4; ++mi) { const int mt = mh * 4 + mi;
            f32x4 aa = (f32x4){0.f, 0.f, 0.f, 0.f}, ax = (f32x4){0.f, 0.f, 0.f, 0.f};
#pragma unroll
            for (int ks = 0; ks < 4; ++ks) { const bf16x8 af = *(const LAS bf16x8*)(XCB + (mt * 16 + l15) * 136 + ks * 32 + 8 * l4);
                aa = __builtin_amdgcn_mfma_f32_16x16x32_bf16(af, bwa[ks], aa, 0, 0, 0); ax = __builtin_amdgcn_mfma_f32_16x16x32_bf16(af, bwx[ks], ax, 0, 0, 0); }
#pragma unroll
            for (int j = 0; j < 4; ++j) { const int tt = mt * 16 + l4 * 4 + j; const float xc = bf2f(XCB[tt * 136 + ch0 + 16 * nt + l15]);
                const float r = sigmoidf_(aa[j] + cba), ig = sigmoidf_(ax[j] + cbx);
                const float la = r * csp, bb = __builtin_amdgcn_sqrtf(1.0f - __expf(2.0f * la)) * ig * xc;
                LAB[tt * 64 + 16 * nt + l15] = f2bf(la); BBB[tt * 64 + 16 * nt + l15] = f2bf(bb); } }
        __syncthreads();
        u32x2 la4[4], bb4[4]; int lr[4];
#pragma unroll
        for (int i = 0; i < 4; ++i) { lr[i] = d ? (BS - 1 - (seg * 4 + i)) : (seg * 4 + i); la4[i] = *(const LAS u32x2*)(LAB + lr[i] * 64 + 4 * cl); bb4[i] = *(const LAS u32x2*)(BBB + lr[i] * 64 + 4 * cl); }
        float h[4] = {0.f, 0.f, 0.f, 0.f}, A[4] = {0.f, 0.f, 0.f, 0.f};
#pragma unroll
        for (int i = 0; i < 4; ++i) { const float l0 = bflo(la4[i].x), l1 = bfhi(la4[i].x), l2 = bflo(la4[i].y), l3 = bfhi(la4[i].y);
            h[0] = __expf(l0) * h[0] + bflo(bb4[i].x); h[1] = __expf(l1) * h[1] + bfhi(bb4[i].x); h[2] = __expf(l2) * h[2] + bflo(bb4[i].y); h[3] = __expf(l3) * h[3] + bfhi(bb4[i].y);
            A[0] += l0; A[1] += l1; A[2] += l2; A[3] += l3; }
        *(LAS f32x4*)(HE + seg * 64 + 4 * cl) = (f32x4){h[0], h[1], h[2], h[3]}; *(LAS f32x4*)(AT + seg * 64 + 4 * cl) = (f32x4){A[0], A[1], A[2], A[3]};
        __syncthreads();
        if (sg == 0) { float hw[4] = {0.f, 0.f, 0.f, 0.f}, aw[4] = {0.f, 0.f, 0.f, 0.f};
#pragma unroll
            for (int s2 = 0; s2 < 4; ++s2) { const f32x4 a4 = *(const LAS f32x4*)(AT + (4 * w + s2) * 64 + 4 * cl), h4 = *(const LAS f32x4*)(HE + (4 * w + s2) * 64 + 4 * cl);
#pragma unroll
                for (int q = 0; q < 4; ++q) { hw[q] = __expf(a4[q]) * hw[q] + h4[q]; aw[q] += a4[q]; } }
            *(LAS f32x4*)(WH + w * 64 + 4 * cl) = (f32x4){hw[0], hw[1], hw[2], hw[3]}; *(LAS f32x4*)(WA + w * 64 + 4 * cl) = (f32x4){aw[0], aw[1], aw[2], aw[3]}; }
        __syncthreads();
        { const f32x4 c4 = *(const LAS f32x4*)(CR + (kb & 1) * 64 + 4 * cl); h[0] = c4[0]; h[1] = c4[1]; h[2] = c4[2]; h[3] = c4[3]; }
        for (int w2 = 0; w2 < w; ++w2) { const f32x4 a4 = *(const LAS f32x4*)(WA + w2 * 64 + 4 * cl), h4 = *(const LAS f32x4*)(WH + w2 * 64 + 4 * cl);
#pragma unroll
            for (int q = 0; q < 4; ++q) h[q] = __expf(a4[q]) * h[q] + h4[q]; }
        for (int s2 = 4 * w; s2 < seg; ++s2) { const f32x4 a4 = *(const LAS f32x4*)(AT + s2 * 64 + 4 * cl), h4 = *(const LAS f32x4*)(HE + s2 * 64 + 4 * cl);
#pragma unroll
            for (int q = 0; q < 4; ++q) h[q] = __expf(a4[q]) * h[q] + h4[q]; }
#pragma unroll
        for (int i = 0; i < 4; ++i) {
            h[0] = __expf(bflo(la4[i].x)) * h[0] + bflo(bb4[i].x); h[1] = __expf(bfhi(la4[i].x)) * h[1] + bfhi(bb4[i].x); h[2] = __expf(bflo(la4[i].y)) * h[2] + bflo(bb4[i].y); h[3] = __expf(bfhi(la4[i].y)) * h[3] + bfhi(bb4[i].y);
            u32x2 o2; o2.x = pk2c(h[0], h[1]); o2.y = pk2c(h[2], h[3]); *(u32x2*)(HD + (size_t)(rowbase + tlo + lr[i]) * 1024 + 4 * cl) = o2; }
        if (seg == 31) *(LAS f32x4*)(CR + ((kb + 1) & 1) * 64 + 4 * cl) = (f32x4){h[0], h[1], h[2], h[3]};
    }
}

__device__ __forceinline__ void hgrn_scan_unit(const Frame& F, int u) {
    const int b = u >> 5, h = (u >> 2) & 7, d = (u >> 1) & 1, eh = u & 1;
    LAS float* FS = (LAS float*)F.lds;
    LAS float* QS = FS + 32 * 128;
    LAS float* VS = QS + 32 * 128;
    LAS float* OP = VS + 32 * 64;
    const bf16_t* U0 = F.w<const bf16_t>(WS_U0);
    bf16_t* OD = F.w<bf16_t>(WS_OD) + (size_t)d * R * 1024 + h * 128 + eh * 64;
    const int fcol = (d ? U0_FB : U0_FF) + h * 128, qcol = U0_Q + h * 128, vcol = U0_I + h * 128 + eh * 64;
    const int si = F.tid >> 4, c8 = (F.tid & 15) * 8;
    const int vi = F.tid >> 3, v8 = (F.tid & 7) * 8;
    float lbv[8];
#pragma unroll
    for (int q = 0; q < 8; ++q) lbv[q] = F.w<const float>(WS_LB)[d * 1024 + h * 128 + c8 + q];
    float S[16];
#pragma unroll
    for (int i = 0; i < 16; ++i) S[i] = 0.f;
    u32x4 rf, rq, rv = (u32x4){0u, 0u, 0u, 0u};
    { const size_t ro = (size_t)step_row(si, b, d) * EVN; rf = *(const u32x4*)(U0 + ro + fcol + c8); rq = *(const u32x4*)(U0 + ro + qcol + c8);
      if (F.tid < 256) rv = *(const u32x4*)(U0 + (size_t)step_row(vi, b, d) * EVN + vcol + v8); }
#pragma unroll 1
    for (int blk = 0; blk < KSEQ / 32; ++blk) {
        { float fo[8], qo[8]; unpack8(rf, fo); unpack8(rq, qo);
#pragma unroll
          for (int q = 0; q < 8; ++q) { FS[si * 128 + c8 + q] = lbv[q] + (1.0f - lbv[q]) * sigmoidf_(fo[q]); QS[si * 128 + c8 + q] = siluf_(qo[q]); }
          if (F.tid < 256) { float vo[8]; unpack8(rv, vo);
#pragma unroll
              for (int q = 0; q < 8; ++q) VS[vi * 64 + v8 + q] = vo[q]; } }
        __syncthreads();
        if (blk + 1 < KSEQ / 32) { const int s = (blk + 1) * 32; const size_t ro = (size_t)step_row(s + si, b, d) * EVN; rf = *(const u32x4*)(U0 + ro + fcol + c8); rq = *(const u32x4*)(U0 + ro + qcol + c8);
            if (F.tid < 256) rv = *(const u32x4*)(U0 + (size_t)step_row(s + vi, b, d) * EVN + vcol + v8); }
#pragma unroll 2
        for (int i = 0; i < 32; ++i) {
            const LAS f32x4* fp = (const LAS f32x4*)(FS + i * 128 + F.wave * 16); const LAS f32x4* qp = (const LAS f32x4*)(QS + i * 128 + F.wave * 16);
            const float v = VS[i * 64 + F.lane]; float o = 0.f;
#pragma unroll
            for (int g = 0; g < 4; ++g) { const f32x4 f4 = fp[g], q4 = qp[g];
#pragma unroll
                for (int q = 0; q < 4; ++q) { float s_ = S[4 * g + q]; s_ = f4[q] * (s_ - v) + v; S[4 * g + q] = s_; o += q4[q] * s_; } }
            OP[(i * 8 + F.wave) * 64 + F.lane] = o;
        }
        __syncthreads();
        { const int i = F.tid >> 4, e4 = (F.tid & 15) * 4; f32x4 a = (f32x4){0.f, 0.f, 0.f, 0.f};
#pragma unroll
          for (int w = 0; w < 8; ++w) a += *(const LAS f32x4*)(OP + (i * 8 + w) * 64 + e4);
          u32x2 o2; o2.x = pk2(a[0], a[1]); o2.y = pk2(a[2], a[3]);
          *(u32x2*)(OD + (size_t)step_row(blk * 32 + i, b, d) * 1024 + e4) = o2; }
    }
}

struct Mix0Raw { u32x4 of[2], ob[2], g[2], hf[2], hb[2], lg[2]; };
__device__ __forceinline__ void mix0_load(const Frame& F, int r, int c0, Mix0Raw& x) {
    const bf16_t* U0 = F.w<const bf16_t>(WS_U0); const bf16_t* OD = F.w<const bf16_t>(WS_OD); const bf16_t* HD = F.w<const bf16_t>(WS_HD);
#pragma unroll
    for (int hh = 0; hh < 2; ++hh) {
        x.of[hh] = *(const u32x4*)(OD + (size_t)r * 1024 + c0 + 8 * hh); x.ob[hh] = *(const u32x4*)(OD + ((size_t)R + r) * 1024 + c0 + 8 * hh);
        x.g[hh] = *(const u32x4*)(U0 + (size_t)r * EVN + U0_G + c0 + 8 * hh);
        x.hf[hh] = *(const u32x4*)(HD + (size_t)r * 1024 + c0 + 8 * hh); x.hb[hh] = *(const u32x4*)(HD + ((size_t)R + r) * 1024 + c0 + 8 * hh);
        x.lg[hh] = *(const u32x4*)(U0 + (size_t)r * EVN + U0_LG + c0 + 8 * hh); }
}
__device__ __forceinline__ void phase_mix0_finish(const Frame& F) {
    const int c0 = F.lane * 16;
    float gain[16];
#pragma unroll
    for (int q = 0; q < 16; ++q) gain[q] = F.in[I_HGON][c0 + q];
    Mix0Raw nx;
    const int per = (R + F.G - 1) / F.G, rbeg = xcd_chunk(F) * per, rend = (rbeg + per < R) ? rbeg + per : R;
    if (rbeg + F.wave < rend) mix0_load(F, rbeg + F.wave, c0, nx);
    for (int r = rbeg + F.wave; r < rend; r += NWAVES) {
        const Mix0Raw x = nx;
        if (r + NWAVES < rend) mix0_load(F, r + NWAVES, c0, nx);
        float o[16], t8[8], u8[8];
#pragma unroll
        for (int hh = 0; hh < 2; ++hh) { unpack8(x.of[hh], t8); unpack8(x.ob[hh], u8);
#pragma unroll
            for (int q = 0; q < 8; ++q) o[8 * hh + q] = t8[q] + u8[q]; }
        float ss = 0.f;
#pragma unroll
        for (int q = 0; q < 16; ++q) ss += o[q] * o[q];
        ss += __shfl_xor(ss, 1); ss += __shfl_xor(ss, 2); ss += __shfl_xor(ss, 4);
        const float rinv = rsqrtf(ss * (1.0f / 128.0f) + EPS);
        bf16_t* yr = F.w<bf16_t>(WS_Y) + (size_t)r * D;
#pragma unroll
        for (int hh = 0; hh < 2; ++hh) { unpack8(x.g[hh], t8); float y[8];
#pragma unroll
            for (int q = 0; q < 8; ++q) y[q] = o[8 * hh + q] * rinv * gain[8 * hh + q] * siluf_(t8[q]);
            u32x4 w; w.x = pk2c(y[0], y[1]); w.y = pk2c(y[2], y[3]); w.z = pk2c(y[4], y[5]); w.w = pk2c(y[6], y[7]); *(u32x4*)(yr + c0 + 8 * hh) = w; }
#pragma unroll
        for (int hh = 0; hh < 2; ++hh) { float a8[8], b8[8], g8[8]; unpack8(x.hf[hh], a8); unpack8(x.hb[hh], b8); unpack8(x.lg[hh], g8);
#pragma unroll
            for (int q = 0; q < 8; ++q) a8[q] = (a8[q] + b8[q]) * gelu_tanh_(g8[q]);
            u32x4 w; w.x = pk2c(a8[0], a8[1]); w.y = pk2c(a8[2], a8[3]); w.z = pk2c(a8[4], a8[5]); w.w = pk2c(a8[6], a8[7]); *(u32x4*)(yr + 1024 + c0 + 8 * hh) = w; }
    }
}
__device__ __forceinline__ void hgrn_chunk_unit(const Frame& F, int u) {
    const int b = u >> 5, h = (u >> 2) & 7, d = (u >> 1) & 1, eh = u & 1;
    constexpr int SQ = 136, ST_ = 72;
    LAS bf16_t* QG = (LAS bf16_t*)F.lds;
    LAS bf16_t* KG = QG + 64 * SQ;
    LAS bf16_t* KLT = KG + 64 * SQ;
    LAS bf16_t* VT = KLT + 128 * ST_;
    LAS bf16_t* STT = VT + 64 * ST_;
    LAS bf16_t* ATT = STT + 64 * SQ;
    LAS bf16_t* OS = ATT + 64 * ST_;
    LAS float* DEC = (LAS float*)(OS + 64 * ST_);
    LAS float* CSQ = DEC + 128;
    const bf16_t* U0 = F.w<const bf16_t>(WS_U0);
    bf16_t* OD = F.w<bf16_t>(WS_OD) + (size_t)d * R * 1024 + h * 128 + eh * 64;
    const int fcol = (d ? U0_FB : U0_FF) + h * 128, qcol = U0_Q + h * 128, vcol = U0_I + h * 128 + eh * 64;
    const int w = F.wave, dp = F.lane;
    const int l15 = F.lane & 15, l4 = F.lane >> 4;
    const float lb0 = F.w<const float>(WS_LB)[d * 1024 + h * 128 + 2 * dp], lb1 = F.w<const float>(WS_LB)[d * 1024 + h * 128 + 2 * dp + 1];
    for (int i = F.tid; i < 64 * SQ / 2; i += NTHR) ((LAS unsigned*)STT)[i] = 0u;
    f32x4 sacc[4];
#pragma unroll
    for (int te = 0; te < 4; ++te) sacc[te] = (f32x4){0.f, 0.f, 0.f, 0.f};
    unsigned rfA[8], rqA[8], rfB[8], rqB[8]; unsigned short rvA[8], rvB[8];
    const long sgn = d ? -(long)EVN : (long)EVN;
#define HG_LOAD(n, rf, rq, rv) do { const bf16_t* base = U0 + (size_t)step_row((n) * 64, b, d) * EVN + (long)(8 * w) * sgn; \
        _Pragma("unroll") for (int i = 0; i < 8; ++i) { const bf16_t* rp = base + (long)i * sgn; rf[i] = *(const unsigned*)(rp + fcol + 2 * dp); rq[i] = *(const unsigned*)(rp + qcol + 2 * dp); rv[i] = rp[vcol + F.lane]; } } while (0)
    HG_LOAD(0, rfA, rqA, rvA); HG_LOAD(1, rfB, rqB, rvB);
    if (w >= 4) __builtin_amdgcn_s_setprio(1);
#pragma unroll 1
    for (int n2 = 0; n2 < KSEQ / 64; n2 += 2) {
        { const int n = n2;

        float k0[8], k1[8], g0[8], g1[8]; float run0 = 0.f, run1 = 0.f;
#pragma unroll
        for (int i = 0; i < 8; ++i) { const float la = bflo(rfA[i]), lc = bfhi(rfA[i]);
            run0 += la; run1 += lc; g0[i] = run0; g1[i] = run1; k0[i] = 1.0f - __builtin_amdgcn_exp2f(la); k1[i] = 1.0f - __builtin_amdgcn_exp2f(lc); }
        *(LAS f32x2*)(CSQ + w * 128 + 2 * dp) = (f32x2){run0, run1};
        { u32x4 wv; wv.x = (unsigned)rvA[0] | ((unsigned)rvA[1] << 16); wv.y = (unsigned)rvA[2] | ((unsigned)rvA[3] << 16); wv.z = (unsigned)rvA[4] | ((unsigned)rvA[5] << 16); wv.w = (unsigned)rvA[6] | ((unsigned)rvA[7] << 16);
          *(LAS u32x4*)(VT + F.lane * ST_ + 8 * w) = wv; }
        __syncthreads();
        float off0 = 0.f, off1 = 0.f, gl0 = 0.f, gl1 = 0.f;
#pragma unroll
        for (int q = 0; q < 8; ++q) { const f32x2 c = *(const LAS f32x2*)(CSQ + q * 128 + 2 * dp); off0 += (q < w) ? c[0] : 0.f; off1 += (q < w) ? c[1] : 0.f; gl0 += c[0]; gl1 += c[1]; }
        const float dc0 = __builtin_amdgcn_exp2f(gl0), dc1 = __builtin_amdgcn_exp2f(gl1);
        if (w == 0) *(LAS f32x2*)(DEC + 2 * dp) = (f32x2){dc0, dc1};
        unsigned kl0[4], kl1[4];
#pragma unroll
        for (int i = 0; i < 8; ++i) {
            const float en0 = __builtin_amdgcn_exp2f(fminf(-(off0 + g0[i]), 115.f)), en1 = __builtin_amdgcn_exp2f(fminf(-(off1 + g1[i]), 115.f));
            const float kg0 = k0[i] * en0, kg1 = k1[i] * en1;
            const float qg0 = bflo(rqA[i]) * __builtin_amdgcn_rcpf(en0), qg1 = bfhi(rqA[i]) * __builtin_amdgcn_rcpf(en1);
            *(LAS unsigned*)(QG + (8 * w + i) * SQ + 2 * dp) = pk2c(qg0, qg1); *(LAS unsigned*)(KG + (8 * w + i) * SQ + 2 * dp) = pk2c(kg0, kg1);
            const unsigned a = pk2c(kg0 * dc0, kg1 * dc1);
            if (i & 1) { kl0[i >> 1] |= a << 16; kl1[i >> 1] |= a & 0xffff0000u; } else { kl0[i >> 1] = a & 0xffffu; kl1[i >> 1] = a >> 16; } }
        *(LAS u32x4*)(KLT + (2 * dp) * ST_ + 8 * w) = (u32x4){kl0[0], kl0[1], kl0[2], kl0[3]};
        *(LAS u32x4*)(KLT + (2 * dp + 1) * ST_ + 8 * w) = (u32x4){kl1[0], kl1[1], kl1[2], kl1[3]};
        __syncthreads();
        if (n + 2 < KSEQ / 64) HG_LOAD(n + 2, rfA, rqA, rvA);
#pragma unroll
        for (int tt = 0; tt < 2; ++tt) { const int t = w + 8 * tt, ti = t >> 2, tj = t & 3;
            f32x4 acc = (f32x4){0.f, 0.f, 0.f, 0.f};
            if (tj <= ti) {
#pragma unroll
                for (int ks = 0; ks < 4; ++ks) { const bf16x8 a = *(const LAS bf16x8*)(QG + (16 * ti + l15) * SQ + ks * 32 + 8 * l4), bb = *(const LAS bf16x8*)(KG + (16 * tj + l15) * SQ + ks * 32 + 8 * l4);
                    acc = __builtin_amdgcn_mfma_f32_16x16x32_bf16(bb, a, acc, 0, 0, 0); } }
            { const int i = 16 * ti + l15, j0 = 16 * tj + 4 * l4; u32x2 o2;
              o2.x = pk2c(j0 <= i ? acc[0] : 0.f, j0 + 1 <= i ? acc[1] : 0.f); o2.y = pk2c(j0 + 2 <= i ? acc[2] : 0.f, j0 + 3 <= i ? acc[3] : 0.f);
              *(LAS u32x2*)(ATT + i * ST_ + j0) = o2; } }
        __syncthreads();
#pragma unroll
        for (int tt = 0; tt < 2; ++tt) { const int t = w + 8 * tt, ti = t >> 2, te = t & 3;
            f32x4 acc = (f32x4){0.f, 0.f, 0.f, 0.f};
#pragma unroll
            for (int ks = 0; ks < 4; ++ks) { const bf16x8 a = *(const LAS bf16x8*)(QG + (16 * ti + l15) * SQ + ks * 32 + 8 * l4), bb = *(const LAS bf16x8*)(STT + (16 * te + l15) * SQ + ks * 32 + 8 * l4);
                acc = __builtin_amdgcn_mfma_f32_16x16x32_bf16(bb, a, acc, 0, 0, 0); }
#pragma unroll
            for (int ks = 0; ks < 2; ++ks) { const bf16x8 a = *(const LAS bf16x8*)(ATT + (16 * ti + l15) * ST_ + ks * 32 + 8 * l4), bb = *(const LAS bf16x8*)(VT + (16 * te + l15) * ST_ + ks * 32 + 8 * l4);
                acc = __builtin_amdgcn_mfma_f32_16x16x32_bf16(bb, a, acc, 0, 0, 0); }
            { u32x2 o2; o2.x = pk2c(acc[0], acc[1]); o2.y = pk2c(acc[2], acc[3]); *(LAS u32x2*)(OS + (16 * ti + l15) * ST_ + 16 * te + 4 * l4) = o2; } }
        { float dc[4];
#pragma unroll
          for (int r = 0; r < 4; ++r) dc[r] = DEC[16 * w + 4 * l4 + r];
          bf16x8 a0 = *(const LAS bf16x8*)(KLT + (16 * w + l15) * ST_ + 8 * l4), a1 = *(const LAS bf16x8*)(KLT + (16 * w + l15) * ST_ + 32 + 8 * l4);
#pragma unroll
          for (int te = 0; te < 4; ++te) {
#pragma unroll
              for (int r = 0; r < 4; ++r) sacc[te][r] *= dc[r];
              const bf16x8 b0 = *(const LAS bf16x8*)(VT + (16 * te + l15) * ST_ + 8 * l4), b1 = *(const LAS bf16x8*)(VT + (16 * te + l15) * ST_ + 32 + 8 * l4);
              sacc[te] = __builtin_amdgcn_mfma_f32_16x16x32_bf16(a0, b0, sacc[te], 0, 0, 0);
              sacc[te] = __builtin_amdgcn_mfma_f32_16x16x32_bf16(a1, b1, sacc[te], 0, 0, 0); } }
        __syncthreads();
#pragma unroll
        for (int te = 0; te < 4; ++te) { u32x2 o2; o2.x = pk2c(sacc[te][0], sacc[te][1]); o2.y = pk2c(sacc[te][2], sacc[te][3]);
            *(LAS u32x2*)(STT + (16 * te + l15) * SQ + 16 * w + 4 * l4) = o2; }
        { const int i = F.tid >> 3, c8 = (F.tid & 7) * 8;
          *(u32x4*)(OD + (size_t)step_row(n * 64 + i, b, d) * 1024 + c8) = *(const LAS u32x4*)(OS + i * ST_ + c8); }
            }
        { const int n = n2 + 1;

        float k0[8], k1[8], g0[8], g1[8]; float run0 = 0.f, run1 = 0.f;
#pragma unroll
        for (int i = 0; i < 8; ++i) { const float la = bflo(rfB[i]), lc = bfhi(rfB[i]);
            run0 += la; run1 += lc; g0[i] = run0; g1[i] = run1; k0[i] = 1.0f - __builtin_amdgcn_exp2f(la); k1[i] = 1.0f - __builtin_amdgcn_exp2f(lc); }
        *(LAS f32x2*)(CSQ + w * 128 + 2 * dp) = (f32x2){run0, run1};
        { u32x4 wv; wv.x = (unsigned)rvB[0] | ((unsigned)rvB[1] << 16); wv.y = (unsigned)rvB[2] | ((unsigned)rvB[3] << 16); wv.z = (unsigned)rvB[4] | ((unsigned)rvB[5] << 16); wv.w = (unsigned)rvB[6] | ((unsigned)rvB[7] << 16);
          *(LAS u32x4*)(VT + F.lane * ST_ + 8 * w) = wv; }
        __syncthreads();
        float off0 = 0.f, off1 = 0.f, gl0 = 0.f, gl1 = 0.f;
#pragma unroll
        for (int q = 0; q < 8; ++q) { const f32x2 c = *(const LAS f32x2*)(CSQ + q * 128 + 2 * dp); off0 += (q < w) ? c[0] : 0.f; off1 += (q < w) ? c[1] : 0.f; gl0 += c[0]; gl1 += c[1]; }
        const float dc0 = __builtin_amdgcn_exp2f(gl0), dc1 = __builtin_amdgcn_exp2f(gl1);
        if (w == 0) *(LAS f32x2*)(DEC + 2 * dp) = (f32x2){dc0, dc1};
        unsigned kl0[4], kl1[4];
#pragma unroll
        for (int i = 0; i < 8; ++i) {
            const float en0 = __builtin_amdgcn_exp2f(fminf(-(off0 + g0[i]), 115.f)), en1 = __builtin_amdgcn_exp2f(fminf(-(off1 + g1[i]), 115.f));
            const float kg0 = k0[i] * en0, kg1 = k1[i] * en1;
            const float qg0 = bflo(rqB[i]) * __builtin_amdgcn_rcpf(en0), qg1 = bfhi(rqB[i]) * __builtin_amdgcn_rcpf(en1);
            *(LAS unsigned*)(QG + (8 * w + i) * SQ + 2 * dp) = pk2c(qg0, qg1); *(LAS unsigned*)(KG + (8 * w + i) * SQ + 2 * dp) = pk2c(kg0, kg1);
            const unsigned a = pk2c(kg0 * dc0, kg1 * dc1);
            if (i & 1) { kl0[i >> 1] |= a << 16; kl1[i >> 1] |= a & 0xffff0000u; } else { kl0[i >> 1] = a & 0xffffu; kl1[i >> 1] = a >> 16; } }
        *(LAS u32x4*)(KLT + (2 * dp) * ST_ + 8 * w) = (u32x4){kl0[0], kl0[1], kl0[2], kl0[3]};
        *(LAS u32x4*)(KLT + (2 * dp + 1) * ST_ + 8 * w) = (u32x4){kl1[0], kl1[1], kl1[2], kl1[3]};
        __syncthreads();
        if (n + 2 < KSEQ / 64) HG_LOAD(n + 2, rfB, rqB, rvB);
#pragma unroll
        for (int tt = 0; tt < 2; ++tt) { const int t = w + 8 * tt, ti = t >> 2, tj = t & 3;
            f32x4 acc = (f32x4){0.f, 0.f, 0.f, 0.f};
            if (tj <= ti) {
#pragma unroll
                for (int ks = 0; ks < 4; ++ks) { const bf16x8 a = *(const LAS bf16x8*)(QG + (16 * ti + l15) * SQ + ks * 32 + 8 * l4), bb = *(const LAS bf16x8*)(KG + (16 * tj + l15) * SQ + ks * 32 + 8 * l4);
                    acc = __builtin_amdgcn_mfma_f32_16x16x32_bf16(bb, a, acc, 0, 0, 0); } }
            { const int i = 16 * ti + l15, j0 = 16 * tj + 4 * l4; u32x2 o2;
              o2.x = pk2c(j0 <= i ? acc[0] : 0.f, j0 + 1 <= i ? acc[1] : 0.f); o2.y = pk2c(j0 + 2 <= i ? acc[2] : 0.f, j0 + 3 <= i ? acc[3] : 0.f);
              *(LAS u32x2*)(ATT + i * ST_ + j0) = o2; } }
        __syncthreads();
#pragma unroll
        for (int tt = 0; tt < 2; ++tt) { const int t = w + 8 * tt, ti = t >> 2, te = t & 3;
            f32x4 acc = (f32x4){0.f, 0.f, 0.f, 0.f};
#pragma unroll
            for (int ks = 0; ks < 4; ++ks) { const bf16x8 a = *(const LAS bf16x8*)(QG + (16 * ti + l15) * SQ + ks * 32 + 8 * l4), bb = *(const LAS bf16x8*)(STT + (16 * te + l15) * SQ + ks * 32 + 8 * l4);
                acc = __builtin_amdgcn_mfma_f32_16x16x32_bf16(bb, a, acc, 0, 0, 0); }
#pragma unroll
            for (int ks = 0; ks < 2; ++ks) { const bf16x8 a = *(const LAS bf16x8*)(ATT + (16 * ti + l15) * ST_ + ks * 32 + 8 * l4), bb = *(const LAS bf16x8*)(VT + (16 * te + l15) * ST_ + ks * 32 + 8 * l4);
                acc = __builtin_amdgcn_mfma_f32_16x16x32_bf16(bb, a, acc, 0, 0, 0); }
            { u32x2 o2; o2.x = pk2c(acc[0], acc[1]); o2.y = pk2c(acc[2], acc[3]); *(LAS u32x2*)(OS + (16 * ti + l15) * ST_ + 16 * te + 4 * l4) = o2; } }
        { float dc[4];
#pragma unroll
          for (int r = 0; r < 4; ++r) dc[r] = DEC[16 * w + 4 * l4 + r];
          bf16x8 a0 = *(const LAS bf16x8*)(KLT + (16 * w + l15) * ST_ + 8 * l4), a1 = *(const LAS bf16x8*)(KLT + (16 * w + l15) * ST_ + 32 + 8 * l4);
#pragma unroll
          for (int te = 0; te < 4; ++te) {
#pragma unroll
              for (int r = 0; r < 4; ++r) sacc[te][r] *= dc[r];
              const bf16x8 b0 = *(const LAS bf16x8*)(VT + (16 * te + l15) * ST_ + 8 * l4), b1 = *(const LAS bf16x8*)(VT + (16 * te + l15) * ST_ + 32 + 8 * l4);
              sacc[te] = __builtin_amdgcn_mfma_f32_16x16x32_bf16(a0, b0, sacc[te], 0, 0, 0);
              sacc[te] = __builtin_amdgcn_mfma_f32_16x16x32_bf16(a1, b1, sacc[te], 0, 0, 0); } }
        __syncthreads();
#pragma unroll
        for (int te = 0; te < 4; ++te) { u32x2 o2; o2.x = pk2c(sacc[te][0], sacc[te][1]); o2.y = pk2c(sacc[te][2], sacc[te][3]);
            *(LAS u32x2*)(STT + (16 * te + l15) * SQ + 16 * w + 4 * l4) = o2; }
        { const int i = F.tid >> 3, c8 = (F.tid & 7) * 8;
          *(u32x4*)(OD + (size_t)step_row(n * 64 + i, b, d) * 1024 + c8) = *(const LAS u32x4*)(OS + i * ST_ + c8); }
            }
    }
    __builtin_amdgcn_s_setprio(0);
#undef HG_LOAD
}
constexpr int U1_CQ = 0, U1_Z = 512, U1_CKV = 1536, U1_XBC = 2048, U1_KR = 3584, U1_DT = 3648;

__device__ __forceinline__ void phase_l1_prep(const Frame& F) {
    const bf16_t* U1 = F.w<const bf16_t>(WS_U1);
    const f32x2* rope = F.w<const f32x2>(WS_ROPE);
    const int per_ = (R + F.G - 1) / F.G, rbeg_ = xcd_chunk(F) * per_, rend_ = (rbeg_ + per_ < R) ? rbeg_ + per_ : R;
    for (int r = rbeg_ + F.wave; r < rend_; r += NWAVES) {
        const bf16_t* ur = U1 + (size_t)r * ODN;
        int b, t, T, rowbase, pos;
        if (r < RL) { b = r >> 12; t = r & 4095; T = TL; rowbase = b * TL; pos = TC + t; } else { const int rc = r - RL; b = rc >> 8; t = rc & 255; T = TC; rowbase = RL + b * TC; pos = t; }
        { float o[8]; float sq = 0.f, sk = 0.f;
          unpack8(*(const u32x4*)(ur + U1_CKV + F.lane * 8), o);
#pragma unroll
          for (int q = 0; q < 8; ++q) sk += o[q] * o[q];
          if (r < RL) { unpack8(*(const u32x4*)(ur + U1_CQ + F.lane * 8), o);
#pragma unroll
              for (int q = 0; q < 8; ++q) sq += o[q] * o[q]; }
          sk = wave_sum(sk); sq = wave_sum(sq);
          if (F.lane == 0) { F.w<float>(WS_RINV)[r] = rsqrtf(sq * (1.0f / 512.0f) + EPS); F.w<float>(WS_RINV)[R + r] = rsqrtf(sk * (1.0f / 512.0f) + EPS); } }
        if (F.lane < 32) { const unsigned w = *(const unsigned*)(ur + U1_KR + 2 * F.lane); float t1 = bflo(w), t2 = bfhi(w);
            if (r < RL) { const f32x2 cs = rope[t * 32 + F.lane]; const float a = t1 * cs[0] - t2 * cs[1], c = t1 * cs[1] + t2 * cs[0]; t1 = a; t2 = c; }
            const unsigned o = pk2(t1, t2);
#pragma unroll
            for (int h = 0; h < 8; ++h) *(unsigned*)(F.w<bf16_t>(WS_KF) + ((size_t)((b * 8 + h) * KSEQ + pos)) * 192 + 128 + 2 * F.lane) = o; }
        u32x4 xr[3][4]; float tm[4];
#pragma unroll
        for (int k = 0; k < 4; ++k) { const int tt = t + k - 2; const bool ok = tt >= 0 && tt < T; tm[k] = ok ? 1.0f : 0.0f; const bf16_t* np_ = U1 + (size_t)(rowbase + (ok ? tt : t)) * ODN + U1_XBC + F.lane * 8;
#pragma unroll
            for (int j = 0; j < 3; ++j) xr[j][k] = *(const u32x4*)(np_ + j * 512); }
#pragma unroll
        for (int j = 0; j < 3; ++j) { const int c = (j * 64 + F.lane) * 8; float a[8];
            { const f32x4 b0 = *(const f32x4*)(F.in[I_SCB] + c), b1 = *(const f32x4*)(F.in[I_SCB] + c + 4); a[0] = b0[0]; a[1] = b0[1]; a[2] = b0[2]; a[3] = b0[3]; a[4] = b1[0]; a[5] = b1[1]; a[6] = b1[2]; a[7] = b1[3]; }
#pragma unroll
            for (int k = 0; k < 4; ++k) { float o[8]; unpack8(xr[j][k], o);
                const f32x4 w0 = *(const f32x4*)(F.in[I_SCW] + k * 1536 + c) * tm[k], w1 = *(const f32x4*)(F.in[I_SCW] + k * 1536 + c + 4) * tm[k];
                a[0] += w0[0] * o[0]; a[1] += w0[1] * o[1]; a[2] += w0[2] * o[2]; a[3] += w0[3] * o[3]; a[4] += w1[0] * o[4]; a[5] += w1[1] * o[5]; a[6] += w1[2] * o[6]; a[7] += w1[3] * o[7]; }
            u32x4 xw; xw.x = pk2c(siluf_(a[0]), siluf_(a[1])); xw.y = pk2c(siluf_(a[2]), siluf_(a[3])); xw.z = pk2c(siluf_(a[4]), siluf_(a[5])); xw.w = pk2c(siluf_(a[6]), siluf_(a[7]));
            *(u32x4*)(F.w<bf16_t>(WS_XBC) + (size_t)r * 1536 + c) = xw; }
        if (F.lane < 32) { const float raw = bf2f(ur[U1_DT + F.lane]); F.w<float>(WS_DT)[(size_t)r * 32 + F.lane] = softplusf_(raw + F.in[I_SDTB][F.lane]); }
    }
}

__device__ __forceinline__ void ssd_scan_unit(const Frame& F, int u) {
    const int b = u >> 5, d = (u >> 4) & 1, h = u & 15, g = h >> 3;
    LAS float* BS = (LAS float*)F.lds;
    LAS float* CS = BS + 32 * 128;
    LAS float* XD = CS + 32 * 128;
    LAS float* DEC = XD + 32 * 64;
    LAS float* YP = DEC + 64;
    const float* XBC = F.w<const float>(WS_XBC); const float* DT = F.w<const float>(WS_DT);
    const float a = -__expf(F.in[I_SALOG][d * 16 + h]);
    bf16_t* YS = F.w<bf16_t>(WS_YS) + (size_t)d * RL * 1024 + h * 64;
    const int si = F.tid >> 4, c8 = (F.tid & 15) * 8;
    const int xi = F.tid >> 4, x4 = (F.tid & 15) * 4;
    f32x4 rb0, rb1, rc0, rc1, rx; float rdt;
#define SSD_LOAD(s0) do { const size_t ro = (size_t)step_row((s0) + si, b, d); const float* xr = XBC + ro * 1536; \
        rb0 = *(const f32x4*)(xr + 1024 + g * 128 + c8); rb1 = *(const f32x4*)(xr + 1024 + g * 128 + c8 + 4); rc0 = *(const f32x4*)(xr + 1280 + g * 128 + c8); rc1 = *(const f32x4*)(xr + 1280 + g * 128 + c8 + 4); \
        rx = *(const f32x4*)(xr + h * 64 + x4); rdt = DT[ro * 32 + d * 16 + h]; } while (0)
    SSD_LOAD(0);
    float S[16];
#pragma unroll
    for (int i = 0; i < 16; ++i) S[i] = 0.f;
#pragma unroll 1
    for (int blk = 0; blk < KSEQ / 32; ++blk) {
        *(LAS f32x4*)(BS + si * 128 + c8) = rb0; *(LAS f32x4*)(BS + si * 128 + c8 + 4) = rb1; *(LAS f32x4*)(CS + si * 128 + c8) = rc0; *(LAS f32x4*)(CS + si * 128 + c8 + 4) = rc1;
        *(LAS f32x4*)(XD + xi * 64 + x4) = rx * rdt; if ((F.tid & 15) == 0) DEC[si] = __expf(rdt * a);
        __syncthreads();
        if (blk + 1 < KSEQ / 32) SSD_LOAD((blk + 1) * 32);
#pragma unroll 2
        for (int i = 0; i < 32; ++i) {
            const LAS f32x4* bp = (const LAS f32x4*)(BS + i * 128 + F.wave * 16); const LAS f32x4* cp = (const LAS f32x4*)(CS + i * 128 + F.wave * 16);
            const float xd = XD[i * 64 + F.lane], de = DEC[i]; float y = 0.f;
#pragma unroll
            for (int gq = 0; gq < 4; ++gq) { const f32x4 b4 = bp[gq], c4 = cp[gq];
#pragma unroll
                for (int q = 0; q < 4; ++q) { float s_ = S[4 * gq + q]; s_ = de * s_ + xd * b4[q]; S[4 * gq + q] = s_; y += c4[q] * s_; } }
            YP[(i * 8 + F.wave) * 64 + F.lane] = y;
        }
        __syncthreads();
        if (blk >= TC / 32) { const int i = F.tid >> 4, p4 = (F.tid & 15) * 4; f32x4 acc = (f32x4){0.f, 0.f, 0.f, 0.f};
#pragma unroll
            for (int w = 0; w < 8; ++w) acc += *(const LAS f32x4*)(YP + (i * 8 + w) * 64 + p4);
            u32x2 o2; o2.x = pk2(acc[0], acc[1]); o2.y = pk2(acc[2], acc[3]);
            *(u32x2*)(YS + (size_t)step_row(blk * 32 + i, b, d) * 1024 + p4) = o2; }
    }
#undef SSD_LOAD
}

__device__ __forceinline__ void phase_mix1_finish(const Frame& F) {
    const bf16_t* U1 = F.w<const bf16_t>(WS_U1); const bf16_t* YS = F.w<const bf16_t>(WS_YS); const bf16_t* XBC = F.w<const bf16_t>(WS_XBC);
    for (int r = F.gw(); r < RL; r += F.ngw()) {
#pragma unroll
        for (int gq = 0; gq < 2; ++gq) { const int c = gq * 512 + F.lane * 8, h = c >> 6; float yf[8], yb[8], z[8];
            unpack8(*(const u32x4*)(YS + (size_t)r * 1024 + c), yf); unpack8(*(const u32x4*)(YS + ((size_t)RL + r) * 1024 + c), yb); unpack8(*(const u32x4*)(U1 + (size_t)r * ODN + U1_Z + c), z);
            float xs[8]; unpack8(*(const u32x4*)(XBC + (size_t)r * 1536 + c), xs); const float dsk = F.in[I_SD][h];
            float y[8], ss = 0.f;
#pragma unroll
            for (int q = 0; q < 8; ++q) { y[q] = (yf[q] + yb[q] + dsk * xs[q]) * siluf_(z[q]); ss += y[q] * y[q]; }
            const float rinv = rsqrtf(wave_sum(ss) * (1.0f / 512.0f) + EPS);
#pragma unroll
            for (int q = 0; q < 8; ++q) y[q] = y[q] * rinv * F.in[I_SON][c + q];
            u32x4 w; w.x = pk2(y[0], y[1]); w.y = pk2(y[2], y[3]); w.z = pk2(y[4], y[5]); w.w = pk2(y[6], y[7]);
            *(u32x4*)(F.w<bf16_t>(WS_Y) + (size_t)r * D + 1024 + c) = w; }
    }
}
__device__ __forceinline__ void ssd_chunk_unit(const Frame& F, int u) {
    const int b = u >> 5, d = (u >> 4) & 1, h = u & 15, g = h >> 3;
    constexpr int SQ = 136, ST_ = 72;
    LAS bf16_t* CM = (LAS bf16_t*)F.lds;
    LAS bf16_t* BM = CM + 64 * SQ;
    LAS bf16_t* BWT = BM + 64 * SQ;
    LAS bf16_t* XT = BWT + 128 * ST_;
    LAS bf16_t* STT = XT + 64 * ST_;
    LAS bf16_t* ATT = STT + 64 * SQ;
    LAS bf16_t* OS = ATT + 64 * ST_;
    LAS float* CSL = (LAS float*)(OS + 64 * ST_);
    LAS float* DTL = CSL + 64;
    const bf16_t* XBC = F.w<const bf16_t>(WS_XBC); const float* DT = F.w<const float>(WS_DT);
    const float a = -__expf(F.in[I_SALOG][d * 16 + h]);
    bf16_t* YS = F.w<bf16_t>(WS_YS) + (size_t)d * RL * 1024 + h * 64;
    const int np = F.lane;
    const int xp = F.tid & 63, xo = F.tid >> 6;
    const int l15 = F.lane & 15, l4 = F.lane >> 4, w = F.wave;
    for (int i = F.tid; i < 64 * SQ / 2; i += NTHR) ((LAS unsigned*)STT)[i] = 0u;
    f32x4 sacc[4];
#pragma unroll
    for (int tp = 0; tp < 4; ++tp) sacc[tp] = (f32x4){0.f, 0.f, 0.f, 0.f};
    unsigned rb[8], rc[8]; unsigned short rx[8]; float rdt = 0.f;
    const long sgn = d ? -1536l : 1536l;
#define SSD_LOAD(n) do { const bf16_t* base = XBC + (size_t)step_row((n) * 64, b, d) * 1536 + (long)(8 * w) * sgn; \
        _Pragma("unroll") for (int i = 0; i < 8; ++i) { const bf16_t* xr = base + (long)i * sgn; rb[i] = *(const unsigned*)(xr + 1024 + g * 128 + 2 * np); rc[i] = *(const unsigned*)(xr + 1280 + g * 128 + 2 * np); rx[i] = xr[h * 64 + xp]; } \
        if (F.tid < 64) rdt = DT[(size_t)step_row((n) * 64 + F.tid, b, d) * 32 + d * 16 + h]; } while (0)
    SSD_LOAD(0);
    if (w >= 4) __builtin_amdgcn_s_setprio(1);
#pragma unroll 1
    for (int n = 0; n < KSEQ / 64; ++n) {
        if (F.tid < 64) { float c = rdt * a;
#pragma unroll
            for (int o = 1; o < 64; o <<= 1) { const float t = __shfl_up(c, o); if (F.lane >= o) c += t; }
            CSL[F.tid] = c; DTL[F.tid] = rdt; }
#pragma unroll
        for (int i = 0; i < 8; ++i) { *(LAS unsigned*)(CM + (8 * w + i) * SQ + 2 * np) = rc[i]; *(LAS unsigned*)(BM + (8 * w + i) * SQ + 2 * np) = rb[i]; }
        __syncthreads();
        const float cslast = CSL[63];
        { unsigned b0[4], b1[4];
#pragma unroll
          for (int i = 0; i < 8; ++i) { const float wgt = __expf(cslast - CSL[8 * w + i]); const unsigned a2 = pk2c(bflo(rb[i]) * wgt, bfhi(rb[i]) * wgt);
              if (i & 1) { b0[i >> 1] |= a2 << 16; b1[i >> 1] |= a2 & 0xffff0000u; } else { b0[i >> 1] = a2 & 0xffffu; b1[i >> 1] = a2 >> 16; } }
          *(LAS u32x4*)(BWT + (2 * np) * ST_ + 8 * w) = (u32x4){b0[0], b0[1], b0[2], b0[3]};
          *(LAS u32x4*)(BWT + (2 * np + 1) * ST_ + 8 * w) = (u32x4){b1[0], b1[1], b1[2], b1[3]};
          u32x4 xv; xv.x = pk2c(bf2f(rx[0]) * DTL[8 * xo + 0], bf2f(rx[1]) * DTL[8 * xo + 1]); xv.y = pk2c(bf2f(rx[2]) * DTL[8 * xo + 2], bf2f(rx[3]) * DTL[8 * xo + 3]);
          xv.z = pk2c(bf2f(rx[4]) * DTL[8 * xo + 4], bf2f(rx[5]) * DTL[8 * xo + 5]); xv.w = pk2c(bf2f(rx[6]) * DTL[8 * xo + 6], bf2f(rx[7]) * DTL[8 * xo + 7]);
          *(LAS u32x4*)(XT + xp * ST_ + 8 * xo) = xv; }
        __syncthreads();
        const float dcy = __expf(cslast);
        if (n + 1 < KSEQ / 64) SSD_LOAD(n + 1);
#pragma unroll
        for (int tt = 0; tt < 2; ++tt) { const int t = w + 8 * tt, ti = t >> 2, tj = t & 3;
            f32x4 acc = (f32x4){0.f, 0.f, 0.f, 0.f};
            if (tj <= ti) {
#pragma unroll
                for (int ks = 0; ks < 4; ++ks) { const bf16x8 av = *(const LAS bf16x8*)(CM + (16 * ti + l15) * SQ + ks * 32 + 8 * l4), bv = *(const LAS bf16x8*)(BM + (16 * tj + l15) * SQ + ks * 32 + 8 * l4);
                    acc = __builtin_amdgcn_mfma_f32_16x16x32_bf16(bv, av, acc, 0, 0, 0); } }
            const int i = 16 * ti + l15, j0 = 16 * tj + 4 * l4;
            const float csi = CSL[i]; const f32x4 csj = *(const LAS f32x4*)(CSL + j0);
            float e[4];
#pragma unroll
            for (int r = 0; r < 4; ++r) { const float x = acc[r] * __expf(fminf(csi - csj[r], 0.f)); e[r] = (j0 + r <= i) ? x : 0.f; }
            u32x2 o2; o2.x = pk2c(e[0], e[1]); o2.y = pk2c(e[2], e[3]);
            *(LAS u32x2*)(ATT + i * ST_ + j0) = o2; }
        __syncthreads();
#pragma unroll
        for (int tt = 0; tt < 2; ++tt) { const int t = w + 8 * tt, ti = t >> 2, tp = t & 3;
            f32x4 acc = (f32x4){0.f, 0.f, 0.f, 0.f};
#pragma unroll
            for (int ks = 0; ks < 4; ++ks) { const bf16x8 av = *(const LAS bf16x8*)(CM + (16 * ti + l15) * SQ + ks * 32 + 8 * l4), bv = *(const LAS bf16x8*)(STT + (16 * tp + l15) * SQ + ks * 32 + 8 * l4);
                acc = __builtin_amdgcn_mfma_f32_16x16x32_bf16(bv, av, acc, 0, 0, 0); }
            acc *= __expf(CSL[16 * ti + l15]);
#pragma unroll
            for (int ks = 0; ks < 2; ++ks) { const bf16x8 av = *(const LAS bf16x8*)(ATT + (16 * ti + l15) * ST_ + ks * 32 + 8 * l4), bv = *(const LAS bf16x8*)(XT + (16 * tp + l15) * ST_ + ks * 32 + 8 * l4);
                acc = __builtin_amdgcn_mfma_f32_16x16x32_bf16(bv, av, acc, 0, 0, 0); }
            u32x2 o2; o2.x = pk2c(acc[0], acc[1]); o2.y = pk2c(acc[2], acc[3]);
            *(LAS u32x2*)(OS + (16 * ti + l15) * ST_ + 16 * tp + 4 * l4) = o2; }
        { const bf16x8 a0 = *(const LAS bf16x8*)(BWT + (16 * w + l15) * ST_ + 8 * l4), a1 = *(const LAS bf16x8*)(BWT + (16 * w + l15) * ST_ + 32 + 8 * l4);
#pragma unroll
          for (int tp = 0; tp < 4; ++tp) { sacc[tp] *= dcy;
              const bf16x8 b0 = *(const LAS bf16x8*)(XT + (16 * tp + l15) * ST_ + 8 * l4), b1 = *(const LAS bf16x8*)(XT + (16 * tp + l15) * ST_ + 32 + 8 * l4);
              sacc[tp] = __builtin_amdgcn_mfma_f32_16x16x32_bf16(a0, b0, sacc[tp], 0, 0, 0);
              sacc[tp] = __builtin_amdgcn_mfma_f32_16x16x32_bf16(a1, b1, sacc[tp], 0, 0, 0); } }
        __syncthreads();
#pragma unroll
        for (int tp = 0; tp < 4; ++tp) { u32x2 o2; o2.x = pk2c(sacc[tp][0], sacc[tp][1]); o2.y = pk2c(sacc[tp][2], sacc[tp][3]);
            *(LAS u32x2*)(STT + (16 * tp + l15) * SQ + 16 * w + 4 * l4) = o2; }
        if (n >= TC / 64) { const int i = F.tid >> 3, c8 = (F.tid & 7) * 8;
            *(u32x4*)(YS + (size_t)step_row(n * 64 + i, b, d) * 1024 + c8) = *(const LAS u32x4*)(OS + i * ST_ + c8); }
    }
    __builtin_amdgcn_s_setprio(0);
#undef SSD_LOAD
}
namespace att {
constexpr int DQ = 192, DV = 128, NW = 8, QBLK = 32, KVBLK = 64;
constexpr float SCALE = 0.07216878364870322f;
constexpr float THR = 8.f;
constexpr int KROW = 400;
constexpr int SHM_V = KVBLK * DV * 2, SHM_K = KVBLK * KROW, SHM_ATTN = 2 * SHM_V + 2 * SHM_K + NW * 64 * 4;
#define KSWZ(row, colB) ((row) * KROW + (colB))
#define SBAR() __builtin_amdgcn_sched_barrier(0)
__device__ __forceinline__ int crow(int r, int hi) { return (r & 3) + 8 * (r >> 2) + 4 * hi; }
__device__ __forceinline__ void partialSM(f32x16& p0, f32x16& p1, float& m_reg, float& mn, float& alpha) {
  constexpr float C = SCALE * 1.4426950408889634f;
  float pmax = p0[0];
#pragma unroll
  for (int r = 1; r < 16; ++r) pmax = fmaxf(pmax, p0[r]);
#pragma unroll
  for (int r = 0; r < 16; ++r) pmax = fmaxf(pmax, p1[r]);
  { auto rr = __builtin_amdgcn_permlane32_swap(__float_as_uint(pmax), __float_as_uint(pmax), false, false);
    pmax = fmaxf(__uint_as_float(rr[0]), __uint_as_float(rr[1])); }
  if (__builtin_expect(__all(pmax - m_reg <= THR / SCALE), 1)) { mn = m_reg; alpha = 1.f; }
  else { mn = fmaxf(m_reg, pmax); alpha = __builtin_amdgcn_exp2f((m_reg - mn) * C); m_reg = mn; }
  float mnC = -mn * C;
#pragma unroll
  for (int r = 0; r < 16; ++r) p0[r] = fmaf(p0[r], C, mnC);
#pragma unroll
  for (int r = 0; r < 16; ++r) p1[r] = fmaf(p1[r], C, mnC);
#pragma unroll
  for (int r = 0; r < 16; ++r) p0[r] = __builtin_amdgcn_exp2f(p0[r]);
}
__device__ __forceinline__ void finishSM(f32x16& p0, f32x16& p1, float alpha, float& l_reg, bf16x8& pa0, bf16x8& pa1, bf16x8& pa2, bf16x8& pa3) {
#pragma unroll
  for (int r = 0; r < 16; ++r) p1[r] = __builtin_amdgcn_exp2f(p1[r]);
  float ps = 0;
#pragma unroll
  for (int r = 0; r < 16; ++r) ps += p0[r];
#pragma unroll
  for (int r = 0; r < 16; ++r) ps += p1[r];
  { auto rr = __builtin_amdgcn_permlane32_swap(__float_as_uint(ps), __float_as_uint(ps), false, false);
    ps = __uint_as_float(rr[0]) + __uint_as_float(rr[1]); }
  l_reg = l_reg * alpha + ps;
#define PK4(P, BASE, OUT) do { unsigned a0 = pk2(P[BASE + 0], P[BASE + 1]), a1 = pk2(P[BASE + 2], P[BASE + 3]);   \
    unsigned b0 = pk2(P[BASE + 4], P[BASE + 5]), b1 = pk2(P[BASE + 6], P[BASE + 7]);                              \
    auto r0 = __builtin_amdgcn_permlane32_swap(a0, b0, false, false); auto r1 = __builtin_amdgcn_permlane32_swap(a1, b1, false, false); \
    u32x4 w = {r0[0], r1[0], r0[1], r1[1]}; OUT = *reinterpret_cast<bf16x8*>(&w); } while (0)
  PK4(p0, 0, pa0); PK4(p0, 8, pa1); PK4(p1, 0, pa2); PK4(p1, 8, pa3);
#undef PK4
}
__device__ __forceinline__ void qkt(f32x16& p0, f32x16& p1, const char* Ks, const bf16x8* qr, int r32, int hi) {
  p0 = f32x16{}; p1 = f32x16{};
#pragma unroll
  for (int d0 = 0; d0 < 12; ++d0) { int cb = (d0 * 16 + hi * 8) * 2;
    bf16x8 b0 = *reinterpret_cast<const bf16x8*>(Ks + KSWZ(r32, cb));
    bf16x8 b1 = *reinterpret_cast<const bf16x8*>(Ks + KSWZ(32 + r32, cb));
    p0 = __builtin_amdgcn_mfma_f32_32x32x16_bf16(b0, qr[d0], p0, 0, 0, 0);
    p1 = __builtin_amdgcn_mfma_f32_32x32x16_bf16(b1, qr[d0], p1, 0, 0, 0); }
}
__device__ __forceinline__ int v_st(int k, int c) { const int kk = (k & ~0xC) | ((k & 4) << 1) | ((k & 8) >> 1); return ((kk >> 3) * 4 + (c >> 5)) * 512 + ((kk & 7) * 32 + (c & 31)) * 2; }
__device__ __forceinline__ int v_rd_base(int lane) { return ((lane & 3) << 3) | (((lane >> 2) & 3) << 6) | (((lane >> 4) & 1) << 5) | (((lane >> 5) & 1) << 8); }
constexpr int v_rd_off(int d0, int ks, int half) { return d0 * 512 + ks * 4096 + half * 2048; }
template <int OFF> __device__ __forceinline__ s16x4 tr_read(int vb) {
  s16x4 r; asm volatile("ds_read_b64_tr_b16 %0, %1 offset:%2" : "=&v"(r) : "v"(vb), "i"(OFF) : "memory"); return r;
}
template <int D0> __device__ __forceinline__ void pv_one(f32x16& od, int vb, bf16x8 pa0, bf16x8 pa1, bf16x8 pa2, bf16x8 pa3) {
  const s16x4 l0 = tr_read<v_rd_off(D0, 0, 0)>(vb), h0 = tr_read<v_rd_off(D0, 0, 1)>(vb), l1 = tr_read<v_rd_off(D0, 1, 0)>(vb), h1 = tr_read<v_rd_off(D0, 1, 1)>(vb);
  const s16x4 l2 = tr_read<v_rd_off(D0, 2, 0)>(vb), h2 = tr_read<v_rd_off(D0, 2, 1)>(vb), l3 = tr_read<v_rd_off(D0, 3, 0)>(vb), h3 = tr_read<v_rd_off(D0, 3, 1)>(vb);
  asm volatile("s_waitcnt lgkmcnt(0)" ::: "memory"); SBAR();
#define PK(L, H) (bf16x8){L[0], L[1], L[2], L[3], H[0], H[1], H[2], H[3]}
  od = __builtin_amdgcn_mfma_f32_32x32x16_bf16(pa0, PK(l0, h0), od, 0, 0, 0);
  od = __builtin_amdgcn_mfma_f32_32x32x16_bf16(pa1, PK(l1, h1), od, 0, 0, 0);
  od = __builtin_amdgcn_mfma_f32_32x32x16_bf16(pa2, PK(l2, h2), od, 0, 0, 0);
  od = __builtin_amdgcn_mfma_f32_32x32x16_bf16(pa3, PK(l3, h3), od, 0, 0, 0);
#undef PK
}
__device__ __forceinline__ void pv_d0(f32x16* o, int vb, bf16x8 pa0, bf16x8 pa1, bf16x8 pa2, bf16x8 pa3) {
  pv_one<0>(o[0], vb, pa0, pa1, pa2, pa3); pv_one<1>(o[1], vb, pa0, pa1, pa2, pa3); pv_one<2>(o[2], vb, pa0, pa1, pa2, pa3); pv_one<3>(o[3], vb, pa0, pa1, pa2, pa3);
}
__device__ __forceinline__ void pv_all(f32x16* o, int vb, bf16x8 pa0, bf16x8 pa1, bf16x8 pa2, bf16x8 pa3) {
  s16x4 l[4][4], h[4][4];
#define RD(D0) l[D0][0] = tr_read<v_rd_off(D0, 0, 0)>(vb); h[D0][0] = tr_read<v_rd_off(D0, 0, 1)>(vb); l[D0][1] = tr_read<v_rd_off(D0, 1, 0)>(vb); h[D0][1] = tr_read<v_rd_off(D0, 1, 1)>(vb); \
               l[D0][2] = tr_read<v_rd_off(D0, 2, 0)>(vb); h[D0][2] = tr_read<v_rd_off(D0, 2, 1)>(vb); l[D0][3] = tr_read<v_rd_off(D0, 3, 0)>(vb); h[D0][3] = tr_read<v_rd_off(D0, 3, 1)>(vb);
  RD(0) RD(1) RD(2) RD(3)
#undef RD
  asm volatile("s_waitcnt lgkmcnt(0)" ::: "memory"); SBAR();
#define PK(L, H) (bf16x8){L[0], L[1], L[2], L[3], H[0], H[1], H[2], H[3]}
#pragma unroll
  for (int d0 = 0; d0 < 4; ++d0) o[d0] = __builtin_amdgcn_mfma_f32_32x32x16_bf16(pa0, PK(l[d0][0], h[d0][0]), o[d0], 0, 0, 0);
#pragma unroll
  for (int d0 = 0; d0 < 4; ++d0) o[d0] = __builtin_amdgcn_mfma_f32_32x32x16_bf16(pa1, PK(l[d0][1], h[d0][1]), o[d0], 0, 0, 0);
#pragma unroll
  for (int d0 = 0; d0 < 4; ++d0) o[d0] = __builtin_amdgcn_mfma_f32_32x32x16_bf16(pa2, PK(l[d0][2], h[d0][2]), o[d0], 0, 0, 0);
#pragma unroll
  for (int d0 = 0; d0 < 4; ++d0) o[d0] = __builtin_amdgcn_mfma_f32_32x32x16_bf16(pa3, PK(l[d0][3], h[d0][3]), o[d0], 0, 0, 0);
#undef PK
}
template <int SDEPTH>
__device__ __forceinline__ void attn_unit(const bf16_t* __restrict__ Qb, const bf16_t* __restrict__ Kh, const bf16_t* __restrict__ Vh, bf16_t* __restrict__ Ob, int ldo, int seq, char* lds) {
  const int tid = threadIdx.x, wid = tid >> 6, lane = tid & 63, r32 = lane & 31, hi = lane >> 5;
  char* V_lds = lds; char* K_lds = lds + 2 * SHM_V;
  float* ws = (float*)(lds + 2 * SHM_V + 2 * SHM_K) + wid * 64; float* li_l = ws; float* al_l = ws + 32;
  float m_reg = -1e30f, l_reg = 0; f32x16 o[4] = {}; bf16x8 qr[12];
  const bf16_t* Qw = Qb + (long)(wid * QBLK + r32) * DQ + hi * 8;
#pragma unroll
  for (int d0 = 0; d0 < 12; ++d0) qr[d0] = *reinterpret_cast<const bf16x8*>(Qw + d0 * 16);
  const int sr = tid >> 4, sc = (tid & 15) * 8, vst0 = v_st(sr, sc), vst1 = v_st(32 + sr, sc);
  int kro[3], kwo[3];
#pragma unroll
  for (int i = 0; i < 3; ++i) { const int p = tid + 512 * i, row = p / 24, c8 = (p % 24) * 8; kro[i] = row * DQ + c8; kwo[i] = KSWZ(row, c8 * 2); }
  const int vb0 = (int)(uintptr_t)V_lds + v_rd_base(lane);
  struct { bf16x8 vs0, vs1, ks0, ks1, ks2; } sr_[SDEPTH];
#define SLOAD(i, k0) do { sr_[i].vs0 = *reinterpret_cast<const bf16x8*>(&Vh[(long)((k0) + sr) * DV + sc]); sr_[i].vs1 = *reinterpret_cast<const bf16x8*>(&Vh[(long)((k0) + 32 + sr) * DV + sc]); \
    sr_[i].ks0 = *reinterpret_cast<const bf16x8*>(&Kh[(long)(k0) * DQ + kro[0]]); sr_[i].ks1 = *reinterpret_cast<const bf16x8*>(&Kh[(long)(k0) * DQ + kro[1]]); sr_[i].ks2 = *reinterpret_cast<const bf16x8*>(&Kh[(long)(k0) * DQ + kro[2]]); } while (0)
#define SWRITE(b, i) do { *(bf16x8*)(V_lds + (b) * SHM_V + vst0) = sr_[i].vs0; *(bf16x8*)(V_lds + (b) * SHM_V + vst1) = sr_[i].vs1; \
    *(bf16x8*)(K_lds + (b) * SHM_K + kwo[0]) = sr_[i].ks0; *(bf16x8*)(K_lds + (b) * SHM_K + kwo[1]) = sr_[i].ks1; *(bf16x8*)(K_lds + (b) * SHM_K + kwo[2]) = sr_[i].ks2; } while (0)
#define SWAIT() do { if constexpr (SDEPTH == 2) asm volatile("s_waitcnt vmcnt(5)" ::: "memory"); else asm volatile("s_waitcnt vmcnt(0)" ::: "memory"); } while (0)
#define RESC(a) do { if (__any((a) < 1.f)) { if (hi == 0) al_l[r32] = (a); asm volatile("s_waitcnt lgkmcnt(0)" ::: "memory"); \
    _Pragma("unroll") for (int d = 0; d < 4; ++d) _Pragma("unroll") for (int r = 0; r < 16; ++r) o[d][r] *= al_l[crow(r, hi)]; } } while (0)
  f32x16 p0, p1; float mn, al; bf16x8 pa0, pa1, pa2, pa3; const int NT = seq / KVBLK;
  SLOAD(0, 0); asm volatile("s_waitcnt vmcnt(0)" ::: "memory"); SWRITE(0, 0);
#pragma unroll 1
  for (int j = 0; j < NT; ++j) {
    const int bsel = j & 1;
    __syncthreads();
    if (j + 1 < NT) SLOAD(0, (j + 1) * KVBLK);
    SBAR(); qkt(p0, p1, K_lds + bsel * SHM_K, qr, r32, hi);
    partialSM(p0, p1, m_reg, mn, al);
    finishSM(p0, p1, al, l_reg, pa0, pa1, pa2, pa3); SBAR();
    RESC(al);
    pv_d0(o, vb0 + bsel * (int)SHM_V, pa0, pa1, pa2, pa3);
    if (j + 1 < NT) { asm volatile("s_waitcnt vmcnt(0)" ::: "memory"); SWRITE(bsel ^ 1, 0); }
  }
  if (hi == 0) li_l[r32] = l_reg; asm volatile("s_waitcnt lgkmcnt(0)" ::: "memory");
  float rli[16];
#pragma unroll
  for (int r = 0; r < 16; ++r) rli[r] = __builtin_amdgcn_rcpf(li_l[crow(r, hi)]);
  bf16_t* Ow = Ob + (long)(wid * QBLK) * ldo;
#pragma unroll
  for (int r = 0; r < 16; ++r) { int orow = crow(r, hi);
#pragma unroll
    for (int d0 = 0; d0 < 4; ++d0) Ow[(long)orow * ldo + d0 * 32 + r32] = f2bf(o[d0][r] * rli[r]); }
  __syncthreads();
#undef SLOAD
#undef SWRITE
#undef SWAIT
#undef RESC
}
__device__ __forceinline__ void attn_unit_dma(const bf16_t* __restrict__ Qb, const bf16_t* __restrict__ Kh, const bf16_t* __restrict__ Vh, bf16_t* __restrict__ Ob, int ldo, int seq, char* lds) {
  const int tid = threadIdx.x, wid = __builtin_amdgcn_readfirstlane(tid >> 6), lane = tid & 63, r32 = lane & 31, hi = lane >> 5;
  char* V_lds = lds; char* K_lds = lds + 2 * SHM_V;
  LAS char* ldsl = (LAS char*)lds;
  float* ws = (float*)(lds + 2 * SHM_V + 2 * SHM_K) + wid * 64; float* li_l = ws; float* al_l = ws + 32;
  float m_reg = -1e30f, l_reg = 0; f32x16 o[4] = {}; bf16x8 qr[12];
  const bf16_t* Qw = Qb + (long)(wid * QBLK + r32) * DQ + hi * 8;
#pragma unroll
  for (int d0 = 0; d0 < 12; ++d0) qr[d0] = *reinterpret_cast<const bf16x8*>(Qw + d0 * 16);
  int kso[4], vso[2];
#pragma unroll
  for (int i = 0; i < 4; ++i) { const int p = (i * 512 + tid) % 1600, row = p / 25; int c = p % 25; c = c > 23 ? 23 : c; kso[i] = row * DQ + c * 8; }
#pragma unroll
  for (int i = 0; i < 2; ++i) { const int p = i * 512 + tid, sub = p >> 5, within = p & 31, kk = (sub >> 2) * 8 + (within >> 2), k = (kk & ~0xC) | ((kk & 4) << 1) | ((kk & 8) >> 1), c = (sub & 3) * 32 + (within & 3) * 8; vso[i] = k * DV + c; }
  const int vb0 = (int)(uintptr_t)V_lds + v_rd_base(lane);
#define DMA_TILE(buf, k0) do { \
    _Pragma("unroll") for (int i_ = 0; i_ < 2; ++i_) __builtin_amdgcn_global_load_lds((const unsigned*)(Vh + (long)(k0) * DV + vso[i_]), (LAS unsigned*)(ldsl + (buf) * SHM_V + (i_ * 512 + wid * 64) * 16), 16, 0, 0); \
    _Pragma("unroll") for (int i_ = 0; i_ < 3; ++i_) __builtin_amdgcn_global_load_lds((const unsigned*)(Kh + (long)(k0) * DQ + kso[i_]), (LAS unsigned*)(ldsl + 2 * SHM_V + (buf) * SHM_K + (i_ * 512 + wid * 64) * 16), 16, 0, 0); \
    if (wid == 0) __builtin_amdgcn_global_load_lds((const unsigned*)(Kh + (long)(k0) * DQ + kso[3]), (LAS unsigned*)(ldsl + 2 * SHM_V + (buf) * SHM_K + 1536 * 16), 16, 0, 0); } while (0)
#define RESC(a) do { if (__any((a) < 1.f)) { if (hi == 0) al_l[r32] = (a); asm volatile("s_waitcnt lgkmcnt(0)" ::: "memory"); \
    _Pragma("unroll") for (int d = 0; d < 4; ++d) _Pragma("unroll") for (int r = 0; r < 16; ++r) o[d][r] *= al_l[crow(r, hi)]; } } while (0)
  f32x16 p0, p1; float mn, al; bf16x8 pa0, pa1, pa2, pa3; const int NT = seq / KVBLK;
  DMA_TILE(0, 0);
  if (wid >= 4) __builtin_amdgcn_s_setprio(1);
#pragma unroll 1
  for (int j = 0; j < NT; ++j) {
    const int bsel = j & 1;
    asm volatile("s_waitcnt vmcnt(0)" ::: "memory");
    __syncthreads();
    if (j + 1 < NT) DMA_TILE(bsel ^ 1, (j + 1) * KVBLK);
    SBAR(); qkt(p0, p1, K_lds + bsel * SHM_K, qr, r32, hi);
    partialSM(p0, p1, m_reg, mn, al);
    finishSM(p0, p1, al, l_reg, pa0, pa1, pa2, pa3); SBAR();
    RESC(al);
    pv_all(o, vb0 + bsel * (int)SHM_V, pa0, pa1, pa2, pa3);
  }
  __builtin_amdgcn_s_setprio(0);
  if (hi == 0) li_l[r32] = l_reg; asm volatile("s_waitcnt lgkmcnt(0)" ::: "memory");
  float rli[16];
#pragma unroll
  for (int r = 0; r < 16; ++r) rli[r] = __builtin_amdgcn_rcpf(li_l[crow(r, hi)]);
  bf16_t* Ow = Ob + (long)(wid * QBLK) * ldo;
#pragma unroll
  for (int r = 0; r < 16; ++r) { int orow = crow(r, hi);
#pragma unroll
    for (int d0 = 0; d0 < 4; ++d0) Ow[(long)orow * ldo + d0 * 32 + r32] = f2bf(o[d0][r] * rli[r]); }
  __syncthreads();
#undef DMA_TILE
#undef RESC
}
constexpr int SHM_ATTN3 = 3 * SHM_V + 3 * SHM_K + NW * 64 * 4;
__device__ __forceinline__ void qkt_h(f32x16& p, const char* Ks, const bf16x8* qr, int r32, int hi, int half) {
  p = f32x16{};
#pragma unroll
  for (int d0 = 0; d0 < 12; ++d0) { const int cb = (d0 * 16 + hi * 8) * 2;
    const bf16x8 b0 = *reinterpret_cast<const bf16x8*>(Ks + KSWZ(32 * half + r32, cb));
    p = __builtin_amdgcn_mfma_f32_32x32x16_bf16(b0, qr[d0], p, 0, 0, 0); }
}
__device__ __forceinline__ void partialSM_h(f32x16& p, float& m_reg, float& mn, float& alpha) {
  constexpr float C = SCALE * 1.4426950408889634f;
  float pmax = p[0];
#pragma unroll
  for (int r = 1; r < 16; ++r) pmax = fmaxf(pmax, p[r]);
  { auto rr = __builtin_amdgcn_permlane32_swap(__float_as_uint(pmax), __float_as_uint(pmax), false, false);
    pmax = fmaxf(__uint_as_float(rr[0]), __uint_as_float(rr[1])); }
  if (__builtin_expect(__all(pmax - m_reg <= THR / SCALE), 1)) { mn = m_reg; alpha = 1.f; }
  else { mn = fmaxf(m_reg, pmax); alpha = __builtin_amdgcn_exp2f((m_reg - mn) * C); m_reg = mn; }
  const float mnC = -mn * C;
#pragma unroll
  for (int r = 0; r < 16; ++r) p[r] = fmaf(p[r], C, mnC);
#pragma unroll
  for (int r = 0; r < 8; ++r) p[r] = __builtin_amdgcn_exp2f(p[r]);
}
__device__ __forceinline__ void finishSM_h(f32x16& p, float alpha, float& l_reg, bf16x8& pa0, bf16x8& pa1) {
#pragma unroll
  for (int r = 8; r < 16; ++r) p[r] = __builtin_amdgcn_exp2f(p[r]);
  float ps = 0;
#pragma unroll
  for (int r = 0; r < 16; ++r) ps += p[r];
  { auto rr = __builtin_amdgcn_permlane32_swap(__float_as_uint(ps), __float_as_uint(ps), false, false);
    ps = __uint_as_float(rr[0]) + __uint_as_float(rr[1]); }
  l_reg = l_reg * alpha + ps;
#define PK4(P, BASE, OUT) do { unsigned a0 = pk2(P[BASE + 0], P[BASE + 1]), a1 = pk2(P[BASE + 2], P[BASE + 3]);   \
    unsigned b0 = pk2(P[BASE + 4], P[BASE + 5]), b1 = pk2(P[BASE + 6], P[BASE + 7]);                              \
    auto r0 = __builtin_amdgcn_permlane32_swap(a0, b0, false, false); auto r1 = __builtin_amdgcn_permlane32_swap(a1, b1, false, false); \
    u32x4 w = {r0[0], r1[0], r0[1], r1[1]}; OUT = *reinterpret_cast<bf16x8*>(&w); } while (0)
  PK4(p, 0, pa0); PK4(p, 8, pa1);
#undef PK4
}
template <int D0, int KH> __device__ __forceinline__ void pv_half_one(f32x16& od, int vb, bf16x8 pa0, bf16x8 pa1) {
  const s16x4 l0 = tr_read<v_rd_off(D0, 2 * KH, 0)>(vb), h0 = tr_read<v_rd_off(D0, 2 * KH, 1)>(vb), l1 = tr_read<v_rd_off(D0, 2 * KH + 1, 0)>(vb), h1 = tr_read<v_rd_off(D0, 2 * KH + 1, 1)>(vb);
  asm volatile("s_waitcnt lgkmcnt(0)" ::: "memory"); SBAR();
#define PK(L, H) (bf16x8){L[0], L[1], L[2], L[3], H[0], H[1], H[2], H[3]}
  od = __builtin_amdgcn_mfma_f32_32x32x16_bf16(pa0, PK(l0, h0), od, 0, 0, 0);
  od = __builtin_amdgcn_mfma_f32_32x32x16_bf16(pa1, PK(l1, h1), od, 0, 0, 0);
#undef PK
}
template <int KH> __device__ __forceinline__ void pv_half(f32x16* o, int vb, bf16x8 pa0, bf16x8 pa1) {
  pv_half_one<0, KH>(o[0], vb, pa0, pa1); pv_half_one<1, KH>(o[1], vb, pa0, pa1); pv_half_one<2, KH>(o[2], vb, pa0, pa1); pv_half_one<3, KH>(o[3], vb, pa0, pa1);
}
__device__ __forceinline__ void attn_unit_h(const bf16_t* __restrict__ Qb, const bf16_t* __restrict__ Kh, const bf16_t* __restrict__ Vh, bf16_t* __restrict__ Ob, int ldo, int seq, char* lds) {
  const int tid = threadIdx.x, wid = __builtin_amdgcn_readfirstlane(tid >> 6), lane = tid & 63, r32 = lane & 31, hi = lane >> 5;
  char* V_lds = lds; char* K_lds = lds + 3 * SHM_V;
  LAS char* ldsl = (LAS char*)lds;
  float* ws = (float*)(lds + 3 * SHM_V + 3 * SHM_K) + wid * 64; float* li_l = ws; float* al_l = ws + 32;
  float m_reg = -1e30f, l_reg = 0; f32x16 o[4] = {}; bf16x8 qr[12];
  const bf16_t* Qw = Qb + (long)(wid * QBLK + r32) * DQ + hi * 8;
#pragma unroll
  for (int d0 = 0; d0 < 12; ++d0) qr[d0] = *reinterpret_cast<const bf16x8*>(Qw + d0 * 16);
  int kso[4], vso[2];
#pragma unroll
  for (int i = 0; i < 4; ++i) { const int p = (i * 512 + tid) % 1600, row = p / 25; int c = p % 25; c = c > 23 ? 23 : c; kso[i] = row * DQ + c * 8; }
#pragma unroll
  for (int i = 0; i < 2; ++i) { const int p = i * 512 + tid, sub = p >> 5, within = p & 31, kk = (sub >> 2) * 8 + (within >> 2), k = (kk & ~0xC) | ((kk & 4) << 1) | ((kk & 8) >> 1), c = (sub & 3) * 32 + (within & 3) * 8; vso[i] = k * DV + c; }
  const int vb0 = (int)(uintptr_t)V_lds + v_rd_base(lane);
#define DMA_TILE(buf, k0) do { \
    _Pragma("unroll") for (int i_ = 0; i_ < 2; ++i_) __builtin_amdgcn_global_load_lds((const unsigned*)(Vh + (long)(k0) * DV + vso[i_]), (LAS unsigned*)(ldsl + (buf) * SHM_V + (i_ * 512 + wid * 64) * 16), 16, 0, 0); \
    _Pragma("unroll") for (int i_ = 0; i_ < 3; ++i_) __builtin_amdgcn_global_load_lds((const unsigned*)(Kh + (long)(k0) * DQ + kso[i_]), (LAS unsigned*)(ldsl + 3 * SHM_V + (buf) * SHM_K + (i_ * 512 + wid * 64) * 16), 16, 0, 0); \
    if (wid == 0) __builtin_amdgcn_global_load_lds((const unsigned*)(Kh + (long)(k0) * DQ + kso[3]), (LAS unsigned*)(ldsl + 3 * SHM_V + (buf) * SHM_K + 1536 * 16), 16, 0, 0); } while (0)
#define RESC(a) do { if (__any((a) < 1.f)) { if (hi == 0) al_l[r32] = (a); asm volatile("s_waitcnt lgkmcnt(0)" ::: "memory"); \
    _Pragma("unroll") for (int d = 0; d < 4; ++d) _Pragma("unroll") for (int r = 0; r < 16; ++r) o[d][r] *= al_l[crow(r, hi)]; } } while (0)
#define TILE_SYNC() do { asm volatile("s_waitcnt vmcnt(0)" ::: "memory"); __syncthreads(); } while (0)
  f32x16 pA, pB; float mnA, mnB, alA, alB; bf16x8 pa0, pa1; const int NT = seq / KVBLK;
  DMA_TILE(0, 0); DMA_TILE(1, KVBLK);
  TILE_SYNC();
  DMA_TILE(2, 2 * KVBLK);
  qkt_h(pA, K_lds, qr, r32, hi, 0); partialSM_h(pA, m_reg, mnA, alA);
  SBAR(); qkt_h(pB, K_lds, qr, r32, hi, 1);
  finishSM_h(pA, alA, l_reg, pa0, pa1); SBAR();
  pv_half<0>(o, vb0, pa0, pa1); partialSM_h(pB, m_reg, mnB, alB);
  RESC(alB);
  int bp = 0, bc = 1, bn = 2;
#pragma unroll 1
  for (int j = 1; j < NT; ++j) {
    SBAR(); qkt_h(pA, K_lds + bc * SHM_K, qr, r32, hi, 0);
    finishSM_h(pB, alB, l_reg, pa0, pa1); SBAR();
    pv_half<1>(o, vb0 + bp * (int)SHM_V, pa0, pa1); partialSM_h(pA, m_reg, mnA, alA);
    TILE_SYNC();
    if (j + 2 < NT) DMA_TILE(bp, (j + 2) * KVBLK);
    RESC(alA);
    SBAR(); qkt_h(pB, K_lds + bc * SHM_K, qr, r32, hi, 1);
    finishSM_h(pA, alA, l_reg, pa0, pa1); SBAR();
    pv_half<0>(o, vb0 + bc * (int)SHM_V, pa0, pa1); partialSM_h(pB, m_reg, mnB, alB);
    RESC(alB);
    { const int t0 = bp; bp = bc; bc = bn; bn = t0; }
  }
  finishSM_h(pB, alB, l_reg, pa0, pa1); SBAR();
  pv_half<1>(o, vb0 + bp * (int)SHM_V, pa0, pa1);
  if (hi == 0) li_l[r32] = l_reg; asm volatile("s_waitcnt lgkmcnt(0)" ::: "memory");
  float rli[16];
#pragma unroll
  for (int r = 0; r < 16; ++r) rli[r] = __builtin_amdgcn_rcpf(li_l[crow(r, hi)]);
  bf16_t* Ow = Ob + (long)(wid * QBLK) * ldo;
#pragma unroll
  for (int r = 0; r < 16; ++r) { int orow = crow(r, hi);
#pragma unroll
    for (int d0 = 0; d0 < 4; ++d0) Ow[(long)orow * ldo + d0 * 32 + r32] = f2bf(o[d0][r] * rli[r]); }
  __syncthreads();
#undef DMA_TILE
#undef RESC
#undef TILE_SYNC
}
#undef KSWZ
#undef SBAR
}
#ifndef MK_PER_PHASE
#define MK_PER_PHASE 0
#endif
constexpr int NPH = 25;
#ifndef ATT_SDEPTH
#define ATT_SDEPTH 1
#endif

#ifndef HC_G1
#define HC_G1 240
#define HC_G2 184
#define HC_G3 232
#define HC_G4 232
#define HC_G6 232
#endif
#ifndef HC_L0P4
#define HC_L0P4 24064
#define HC_L0G1 16384
#define HC_L0G2 25600
#define HC_L1P4 16896
#define HC_L1G3 19200
#define HC_L1G4 12288
#define HC_L1G6 6400
#endif
constexpr int L0_P4 = HC_L0P4, L0_G1 = L0_P4 + HC_L0G1, L0_G2 = L0_G1 + HC_L0G2;
constexpr int L1_P4 = HC_L1P4, L1_G3 = L1_P4 + HC_L1G3, L1_G4 = L1_G3 + HC_L1G4, L1_G6 = L1_G4 + HC_L1G6;
static_assert(L0_G2 == PL_LO && L0_G2 <= IT_MOE && L1_G6 <= IT_MOE, "helper plan");
__device__ __forceinline__ void helper_convert(const Frame& F, int GG, int l, int lo, int hi) { moe_convert_range(F, l, lo, hi, (F.bid - GG) * NWAVES + F.wave, (F.G - GG) * NWAVES); }

__device__ __forceinline__ void moe_gemms_gateup(const Frame& F, int l, int tM, int GG) {
    pg8::Gemm g{D, D, D};
    pg8::GroupSched S{(const char*)F.w<bf16_t>(WS_H), (const char*)(F.w<bf16_t>(WS_WGU) + (size_t)l * NE * GUN * D), (size_t)256 * D * 2, (size_t)256 * D * 2, tM, 11, NE, GG, F.bid, F.w<const int>(WS_ROWMAP)};
    EpiGateUp E{F.w<bf16_t>(WS_HID)};
    pg8::gemm_phase<EpiGateUp, pg8::GroupSched, true>(F.lds, g, S, E);
}
__device__ __forceinline__ void moe_gemms_down(const Frame& F, int l, int tM, int GG) {
    pg8::Gemm g{FF, FF, FF};
    pg8::GroupSched S{(const char*)F.w<bf16_t>(WS_HID), (const char*)(F.w<bf16_t>(WS_WDN) + (size_t)l * NE * D * FF), (size_t)256 * FF * 2, (size_t)256 * FF * 2, tM, 8, NE, GG, F.bid, nullptr, true};
    EpiDown E{F.w<bf16_t>(WS_YE), F.w<const float>(WS_GROW)};
    pg8::gemm_phase(F.lds, g, S, E);
}

__global__ void __launch_bounds__(NTHR, 2) mk_fwd(Params p) {
    extern __shared__ __attribute__((aligned(16))) unsigned char lds_raw[];
    Frame F;
    F.lds = (LAS unsigned char*)lds_raw; F.in = p.in; F.out = p.out; F.ws = p.ws;
    F.tid = threadIdx.x; F.lane = F.tid & 63; F.wave = __builtin_amdgcn_readfirstlane(F.tid >> 6); F.bid = blockIdx.x; F.G = gridDim.x;
    volatile LAS unsigned* MISC = (volatile LAS unsigned*)(F.lds + LDS_MISC);
    if (F.tid < 64) MISC[F.tid] = 0u;
    __syncthreads();
    XcdBarrier bar; bar.bar = (unsigned*)(p.ws + WS_CTL) + 4096; bar.x = 0; bar.st = nullptr;
#if !MK_PER_PHASE
    bar = xcd_barrier_post((unsigned*)(p.ws + WS_CTL) + 4096, MISC + 8);
#endif
    const int lo = p.ph_lo, hi = p.ph_hi;
#ifndef MK_ONLY
#define MK_ONLY -1
#endif
#ifndef MK_DUP
#define MK_DUP 0u
#endif
#define REP(k) for (int rep_ = 0; rep_ <= (int)((MK_DUP >> (k)) & 1u); ++rep_)
#define IN(k) ((MK_ONLY < 0 || MK_ONLY == (k)) && lo <= (k) && (k) < hi)
#if MK_PER_PHASE
#define SEAM(k) do { } while (0)
#else
#define SEAM(k) do { if (IN(k) && hi > (k) + 1) xcd_barrier(bar); } while (0)
#endif

    if (IN(0)) REP(0) { phase_prologue(F); } SEAM(0);
    if (IN(1)) REP(1) { phase_norm0(F); } SEAM(1);
#ifdef MK_XBAR
    for (int xb_ = 0; xb_ < MK_XBAR; ++xb_) xcd_barrier(bar);
#endif
    const bool full = F.G == 256;
    if (IN(2)) REP(2) {
        const int GG = full ? HC_G1 : F.G;
        if (F.bid < GG) {
        pg8::Gemm g{D, D, D};
        pg8::RectSched S{(const char*)F.w<bf16_t>(WS_H), (const char*)F.w<bf16_t>(WS_WEV), (size_t)256 * D * 2, (size_t)256 * D * 2, R / 256, EVN / 256, (R / 256) * (EVN / 256), GG, F.bid};
        EpiEv E{F.w<bf16_t>(WS_U0), F.w<const float>(WS_LB)};
        pg8::gemm_phase(F.lds, g, S, E);
        } else helper_convert(F, GG, 0, L0_P4, L0_G1);
    } SEAM(2);
    if (IN(4)) REP(4) { for (int u = F.bid; u < 256; u += F.G) { if (u < 128) { for (int r2 = 0; r2 <= (int)((MK_DUP >> 25) & 1u); ++r2) { hgrn_chunk_unit(F, (((u >> 4) << 3 | (u & 7)) << 1) | ((u >> 3) & 1)); __syncthreads(); }        } else { for (int r2 = 0; r2 <= (int)((MK_DUP >> 26) & 1u); ++r2) { lru_fused_unit(F, ((((u - 128) >> 5) * 8 + ((u - 128) & 7)) << 2) | (((u - 128) >> 3) & 3)); __syncthreads(); }        if (F.G == 256) { moe_convert_range(F, 0, 0, L0_P4, (u - 128) * NWAVES + F.wave, 128 * NWAVES); moe_convert_range(F, 1, 0, L1_P4, (u - 128) * NWAVES + F.wave, 128 * NWAVES); } __syncthreads(); } } } SEAM(4);
    if (IN(5)) REP(5) { phase_mix0_finish(F); } SEAM(5);
    if (IN(6)) REP(6) {
        const int GG = full ? HC_G2 : F.G;
        if (F.bid < GG) {
        pg8::Gemm g{D, D, D};
        pg8::RectSched S{(const char*)F.w<bf16_t>(WS_Y), (const char*)F.w<bf16_t>(WS_WO), (size_t)256 * D * 2, (size_t)256 * D * 2, R / 256, D / 256, (R / 256) * (D / 256), GG, F.bid};
        EpiDelta E{F.w<bf16_t>(WS_DELTA), F.w<const float>(WS_MOD)};
        pg8::gemm_phase(F.lds, g, S, E);
        } else helper_convert(F, GG, 0, L0_G1, L0_G2);
    } SEAM(6);
    if (IN(7)) REP(7) { phase_router(F, 0, R); } SEAM(7);
    if (IN(8)) REP(8) { phase_topk(F, 128, MROWS0); } SEAM(8);
    if (IN(10)) REP(10) { const int GG = full ? HC_G3 : F.G; if (F.bid < GG) moe_gemms_gateup(F, 0, MROWS0 / 256, GG); else helper_convert(F, GG, 1, L1_P4, L1_G3); } SEAM(10);
    if (IN(11)) REP(11) { const int GG = full ? HC_G4 : F.G; if (F.bid < GG) moe_gemms_down(F, 0, MROWS0 / 256, GG); else helper_convert(F, GG, 1, L1_G3, L1_G4); } SEAM(11);
    if (IN(12)) REP(12) { phase_combine(F, 0, R, MROWS0, false);
        __syncthreads();
        if (!full) moe_convert_range(F, 1, 0, IT_MOE, F.gw(), F.ngw()); } SEAM(12);
    if (IN(13)) REP(13) {
        pg8::Gemm g{D, D, D};
        const char* A = (const char*)F.w<bf16_t>(WS_H); const char* B = (const char*)F.w<bf16_t>(WS_WOD); const size_t ts = (size_t)256 * D * 2;
        pg8::TwoRectSched S{A, B, A + 64 * ts, B + 6 * ts, ts, ts, RL / 256, ODN / 256, RC / 256, 9, 64, 6, F.G, F.bid};
        EpiStoreBf16 E{F.w<bf16_t>(WS_U1), ODN};
        pg8::gemm_phase(F.lds, g, S, E);
    } SEAM(13);
    if (IN(14)) REP(14) { phase_l1_prep(F); } SEAM(14);
    if (IN(15)) REP(15) {
        const int GG = full ? HC_G6 : F.G;
        if (F.bid < GG) {
        pg8::Gemm g{512, ODN, 512};
        const char* A = (const char*)F.w<bf16_t>(WS_U1);
        pg8::TwoRectSched S{A, (const char*)F.w<bf16_t>(WS_WQ), A + (size_t)U1_CKV * 2, (const char*)F.w<bf16_t>(WS_WKV), (size_t)256 * ODN * 2, (size_t)256 * 512 * 2, RL / 256, 6, R / 256, 8, 0, 0, GG, F.bid};
        EpiMla E{F.w<bf16_t>(WS_Q), F.w<bf16_t>(WS_KF), F.w<bf16_t>(WS_VF), F.w<const float>(WS_RINV), F.w<const f32x2>(WS_ROPE)};
        pg8::gemm_phase(F.lds, g, S, E);
        } else helper_convert(F, GG, 1, L1_G4, L1_G6);
    } SEAM(15);
    if (IN(16)) REP(16) {
        const bf16_t* Q = F.w<const bf16_t>(WS_Q); const bf16_t* KF = F.w<const bf16_t>(WS_KF); const bf16_t* VF = F.w<const bf16_t>(WS_VF); bf16_t* Y = F.w<bf16_t>(WS_Y);
        auto attn = [&](int u) { const int bh = u >> 4, qb = u & 15, b = bh >> 3, h = bh & 7;
            att::attn_unit_dma(Q + ((size_t)bh * TL + qb * 256) * 192, KF + (size_t)bh * KSEQ * 192, VF + (size_t)bh * KSEQ * 128, Y + ((size_t)b * TL + qb * 256) * D + h * 128, D, KSEQ, (char*)lds_raw); };
        for (int u = F.bid; u < 128; u += F.G) for (int r2 = 0; r2 <= (int)((MK_DUP >> 27) & 1u); ++r2) { ssd_chunk_unit(F, u); __syncthreads(); }
        unsigned* qctr = (unsigned*)(p.ws + WS_CTL) + 8192;
        volatile LAS unsigned* qw = MISC + 16;
#pragma unroll 1
        for (;;) {
            if (F.tid == 0) qw[0] = __hip_atomic_fetch_add(qctr, 1u, __ATOMIC_RELAXED, __HIP_MEMORY_SCOPE_AGENT);
            __syncthreads();
            const unsigned u = qw[0];
            __syncthreads();
            if (u >= 512u) break;
            attn((int)u);
        }
        if (full && F.bid < 128) { __syncthreads(); moe_convert_range(F, 1, L1_G6, IT_MOE, F.bid * NWAVES + F.wave, 128 * NWAVES); }
    } SEAM(16);
    if (IN(17)) REP(17) { phase_mix1_finish(F); } SEAM(17);
    if (IN(18)) REP(18) {
        pg8::Gemm g{D, D, D};
        pg8::RectSched S{(const char*)F.w<bf16_t>(WS_Y), (const char*)(F.w<bf16_t>(WS_WO) + (size_t)D * D), (size_t)256 * D * 2, (size_t)256 * D * 2, RL / 256, D / 256, (RL / 256) * (D / 256), F.G, F.bid};
        EpiDelta E{F.w<bf16_t>(WS_DELTA), F.w<const float>(WS_MOD) + 5 * 12288};
        pg8::gemm_phase(F.lds, g, S, E);
    } SEAM(18);
    if (IN(19)) REP(19) { phase_router(F, 1, RL); } SEAM(19);
    if (IN(20)) REP(20) { phase_topk(F, 64, MROWS1); } SEAM(20);
    if (IN(22)) REP(22) { moe_gemms_gateup(F, 1, MROWS1 / 256, F.G); } SEAM(22);
    if (IN(23)) REP(23) { moe_gemms_down(F, 1, MROWS1 / 256, F.G); } SEAM(23);
    if (IN(24)) REP(24) { phase_combine(F, 1, RL, MROWS1, true); }
#undef IN
#undef SEAM
}

extern "C" void kernel_launch(void* const* d_in, const int* in_sizes, int n_in, void* d_out, int out_size, void* d_ws, size_t ws_size, hipStream_t stream) {
    static int grid = 0;
    if (grid == 0) {
        if (n_in != 35 || in_sizes[0] != RL * D || out_size != RL * D || ws_size < WS_END) { fprintf(stderr, "kernel_launch: unexpected shapes (n_in %d, in0 %d, out %d, ws %zu < %zu)\n", n_in, n_in > 0 ? in_sizes[0] : -1, out_size, ws_size, (size_t)WS_END); grid = -1; return; }
        int dev = 0, cus = 0, per_cu = 0;
        if (hipGetDevice(&dev) != hipSuccess || hipDeviceGetAttribute(&cus, hipDeviceAttributeMultiprocessorCount, dev) != hipSuccess) { grid = -1; return; }
        if (hipFuncSetAttribute((const void*)mk_fwd, hipFuncAttributeMaxDynamicSharedMemorySize, LDS_BYTES) != hipSuccess) { fprintf(stderr, "kernel_launch: hipFuncSetAttribute failed\n"); grid = -1; return; }
        if (hipOccupancyMaxActiveBlocksPerMultiprocessor(&per_cu, (const void*)mk_fwd, NTHR, LDS_BYTES) != hipSuccess || per_cu < 1) { fprintf(stderr, "kernel_launch: occupancy query says %d\n", per_cu); }
        (void)hipGetLastError();
        grid = cus;
    }
    if (grid < 0) return;
    (void)hipMemsetAsync((char*)d_ws + WS_CTL, 0, 65536, stream);
    Params p; memset(&p, 0, sizeof(p));
    for (int i = 0; i < 35; ++i) p.in[i] = (const float*)d_in[i];
    p.out = (float*)d_out; p.ws = (unsigned char*)d_ws;
#if MK_PER_PHASE
    for (int k = 0; k < NPH; ++k) { p.ph_lo = k; p.ph_hi = k + 1; hipLaunchKernelGGL(mk_fwd, dim3(grid), dim3(NTHR), LDS_BYTES, stream, p); }
#else
    p.ph_lo = 0; p.ph_hi = NPH; hipLaunchKernelGGL(mk_fwd, dim3(grid), dim3(NTHR), LDS_BYTES, stream, p);
#endif
    const hipError_t le = hipPeekAtLastError();
    if (le != hipSuccess) fprintf(stderr, "kernel_launch: launch failed: %s\n", hipGetErrorName(le));
}
```
